# Optimizing an MI355X kernel written in HIP

```python
import math
import jax, jax.numpy as jnp
from jax import lax
import numpy as np

D_MODEL = 2048
BATCH = 4
SEQ = 2048
DEPTH = 1
DEC_BATCH = 128
DEC_SEQ = 8
PAST_LEN = 2048
PAGE_SIZE = 128

HEAD_DIM = 64
ATTN_WIDTH = D_MODEL // 2
N_HEADS = ATTN_WIDTH // HEAD_DIM
KV_HEADS = 4
Q_PER_KV = N_HEADS // KV_HEADS
CMP_STRIDE = 16
CMP_BLOCK = 2 * CMP_STRIDE
CMP_HIDDEN = 2 * HEAD_DIM
SEL_BLOCK = 64
N_SELECT = 8
WINDOW = 512
QUERY_BLOCK = 128
N_KV_SLOTS = 6
N_CACHE_SLOTS = 4
SSM_INNER = D_MODEL - ATTN_WIDTH
SSM_HEADDIM = 64
SSM_HEADS = SSM_INNER // SSM_HEADDIM
SSM_GROUPS = 4
SSM_HPG = SSM_HEADS // SSM_GROUPS
SSM_STATE = 128
SSM_CONV = 4
SSD_CHUNK = 128
CONV_DIM = SSM_INNER + 2 * SSM_GROUPS * SSM_STATE
MIX_WIDTH = ATTN_WIDTH + SSM_INNER
IN_WIDTH = ATTN_WIDTH + N_KV_SLOTS * KV_HEADS * HEAD_DIM + 3 * N_HEADS + SSM_INNER + CONV_DIM + SSM_HEADS
D_FF = ((8 * D_MODEL // 3 + 127) // 128) * 128
FFN_CONV = 3
REL_BUCKETS = 32
REL_MAX_DIST = 128
EPS = 1e-6
NEG = -1e30
TINY = 1e-30
FORCE_BONUS = 1e4
SCALE = HEAD_DIM ** -0.5

kernel_name = 'hybrid_nsa_ssd_convffn_step'


def rmsnorm(x, g):
    xf = x.astype(jnp.float32)
    y = xf * lax.rsqrt(jnp.mean(xf * xf, -1, keepdims=True) + EPS)
    return (y * g.astype(jnp.float32)).astype(x.dtype)


def masked_softmax(s, mask):
    m = jnp.max(jnp.where(mask, s, NEG), -1, keepdims=True)
    e = jnp.where(mask, jnp.exp(jnp.where(mask, s, m) - m), 0.0)
    return e / jnp.maximum(jnp.sum(e, -1, keepdims=True), TINY)


def rel_bucket(dist):
    n = jnp.maximum(dist, 0)
    max_exact = REL_BUCKETS // 2
    nf = jnp.maximum(n, 1).astype(jnp.float32)
    large = max_exact + (jnp.log(nf / max_exact) / math.log(REL_MAX_DIST / max_exact)
                         * (REL_BUCKETS - max_exact)).astype(jnp.int32)
    large = jnp.minimum(large, REL_BUCKETS - 1)
    return jnp.where(n < max_exact, n, large)


def causal_dwconv(x_full, w, b):
    width = w.shape[0]
    t = x_full.shape[1] - width + 1
    acc = b
    for k in range(width):
        acc = acc + x_full[:, k:k + t] * w[k]
    return acc


def project(x, g_pre, w_in):
    b, t = x.shape[:2]
    p = rmsnorm(x, g_pre) @ w_in
    o1 = ATTN_WIDTH
    o2 = o1 + N_KV_SLOTS * KV_HEADS * HEAD_DIM
    o3 = o2 + 3 * N_HEADS
    o4 = o3 + SSM_INNER
    o5 = o4 + CONV_DIM
    q, kv, gate, z, xbc, dt = jnp.split(p, [o1, o2, o3, o4, o5], axis=-1)
    q = q.reshape(b, t, KV_HEADS, Q_PER_KV, HEAD_DIM)
    kv = kv.reshape(b, t, N_KV_SLOTS, KV_HEADS, HEAD_DIM)
    gate = jax.nn.sigmoid(gate.astype(jnp.float32)).reshape(b, t, 3, KV_HEADS, Q_PER_KV)
    return q, kv, gate, z, xbc, dt


def compress(rows, pe, w1, b1, w2, b2, n_blk):
    b, _, g, d = rows.shape
    ch = rows[:, :(n_blk + 1) * CMP_STRIDE].reshape(b, n_blk + 1, CMP_STRIDE, g, d)
    pe2 = pe.reshape(2, CMP_STRIDE, 1, d)
    w12 = w1.reshape(2, CMP_STRIDE, d, CMP_HIDDEN)
    hid = (jnp.einsum('bnsgd,sdh->bngh', ch[:, :-1] + pe2[0], w12[0])
           + jnp.einsum('bnsgd,sdh->bngh', ch[:, 1:] + pe2[1], w12[1]) + b1)
    return jnp.einsum('bngh,hd->bngd', jax.nn.gelu(hid), w2) + b2


def overlap_map(n_cmp, n_sel):
    c0 = jnp.arange(n_cmp) * CMP_STRIDE
    s0 = jnp.arange(n_sel) * SEL_BLOCK
    ov = jnp.minimum(c0[:, None] + CMP_BLOCK, s0[None, :] + SEL_BLOCK) - jnp.maximum(c0[:, None], s0[None, :])
    return jnp.clip(ov, 0).astype(jnp.float32) / CMP_BLOCK


def gather_blocks(rows, idx):
    b, t, g, d = rows.shape
    kb = rows.reshape(b, t // SEL_BLOCK, SEL_BLOCK, g, d).transpose(0, 3, 1, 2, 4)
    bi = jnp.arange(b)[:, None, None, None]
    gi = jnp.arange(g)[None, None, :, None]
    return kb[bi, gi, idx]


def pad_rows(rows, n):
    return jnp.pad(rows, ((0, 0), (0, n - rows.shape[1]), (0, 0), (0, 0)))


def nsa_block(q, gate, q_pos, kc, vc, c_end, imp_map, k_sel, v_sel, kw, vw, kw_pos, rel_table):
    b, tq, g, r, d = q.shape
    table = rel_table.astype(jnp.float32).reshape(REL_BUCKETS, g, r)
    dist_c = q_pos[:, None] - c_end[None, :]
    bias_c = table[rel_bucket(dist_c)].transpose(0, 2, 3, 1)[None]
    s_c = jnp.einsum('btgrd,bngd->btgrn', q, kc).astype(jnp.float32) * SCALE + bias_c
    p_c = masked_softmax(s_c, (dist_c >= 0)[None, :, None, None, :])
    o_c = jnp.einsum('btgrn,bngd->btgrd', p_c.astype(vc.dtype), vc).astype(jnp.float32)
    ns = imp_map.shape[1]
    imp = jnp.einsum('btgrn,ns->btgs', p_c, imp_map)
    blk = jnp.arange(ns)
    q_blk = q_pos // SEL_BLOCK
    valid = (blk[None, :] <= q_blk[:, None])[None, :, None, :]
    forced = ((blk[None, :] == 0) | (blk[None, :] == q_blk[:, None]) | (blk[None, :] == q_blk[:, None] - 1))
    score = jnp.where(valid, imp + jnp.where(forced, FORCE_BONUS, 0.0)[None, :, None, :], -jnp.inf)
    k_top = min(N_SELECT, ns)
    _, idx = lax.top_k(score, k_top)
    idx_valid = idx <= q_blk[None, :, None, None]
    ks = gather_blocks(k_sel, idx)
    vs = gather_blocks(v_sel, idx)
    kpos = idx[..., None] * SEL_BLOCK + jnp.arange(SEL_BLOCK)
    dist_s = q_pos[None, :, None, None, None] - kpos
    mask_s = (idx_valid[..., None] & (dist_s >= 0)).reshape(b, tq, g, 1, k_top * SEL_BLOCK)
    bias_s = jnp.moveaxis(table[rel_bucket(dist_s), jnp.arange(g)[None, None, :, None, None]], -1, 3)
    s_s = jnp.einsum('btgrd,btgksd->btgrks', q, ks).astype(jnp.float32) * SCALE + bias_s
    p_s = masked_softmax(s_s.reshape(b, tq, g, r, k_top * SEL_BLOCK), mask_s)
    o_s = jnp.einsum('btgrm,btgmd->btgrd', p_s.astype(vs.dtype),
                     vs.reshape(b, tq, g, k_top * SEL_BLOCK, d)).astype(jnp.float32)
    dist_w = q_pos[:, None] - kw_pos[None, :]
    mask_w = (dist_w >= 0) & (dist_w <= WINDOW) & (kw_pos[None, :] >= 0)
    bias_w = table[rel_bucket(dist_w)].transpose(0, 2, 3, 1)[None]
    s_w = jnp.einsum('btgrd,bkgd->btgrk', q, kw).astype(jnp.float32) * SCALE + bias_w
    p_w = masked_softmax(s_w, mask_w[None, :, None, None, :])
    o_w = jnp.einsum('btgrk,bkgd->btgrd', p_w.astype(vw.dtype), vw).astype(jnp.float32)
    o = (gate[:, :, 0, :, :, None] * o_c + gate[:, :, 1, :, :, None] * o_s
         + gate[:, :, 2, :, :, None] * o_w)
    return o.astype(q.dtype).reshape(b, tq, g * r * d)


def nsa_prompt(q, kv, gate, cmp_pe, cmp_w1, cmp_b1, cmp_w2, cmp_b2, rel_table):
    b, t = q.shape[:2]
    n_cmp = (t - CMP_BLOCK) // CMP_STRIDE + 1
    kc = compress(kv[:, :, 0], cmp_pe[0], cmp_w1[0], cmp_b1[0], cmp_w2[0], cmp_b2[0], n_cmp)
    vc = compress(kv[:, :, 1], cmp_pe[1], cmp_w1[1], cmp_b1[1], cmp_w2[1], cmp_b2[1], n_cmp)
    c_end = jnp.arange(n_cmp) * CMP_STRIDE + CMP_BLOCK - 1
    n_sel = -(-t // SEL_BLOCK)
    imp_map = overlap_map(n_cmp, n_sel)
    k_sel = pad_rows(kv[:, :, 2], n_sel * SEL_BLOCK)
    v_sel = pad_rows(kv[:, :, 3], n_sel * SEL_BLOCK)
    pad_w = ((0, 0), (WINDOW, 0), (0, 0), (0, 0))
    kw_pad = jnp.pad(kv[:, :, 4], pad_w)
    vw_pad = jnp.pad(kv[:, :, 5], pad_w)

    def one_block(i):
        s = i * QUERY_BLOCK
        qb = lax.dynamic_slice_in_dim(q, s, QUERY_BLOCK, 1)
        gb = lax.dynamic_slice_in_dim(gate, s, QUERY_BLOCK, 1)
        q_pos = s + jnp.arange(QUERY_BLOCK)
        kwb = lax.dynamic_slice_in_dim(kw_pad, s, WINDOW + QUERY_BLOCK, 1)
        vwb = lax.dynamic_slice_in_dim(vw_pad, s, WINDOW + QUERY_BLOCK, 1)
        kw_pos = s - WINDOW + jnp.arange(WINDOW + QUERY_BLOCK)
        return nsa_block(qb, gb, q_pos, kc, vc, c_end, imp_map, k_sel, v_sel, kwb, vwb, kw_pos, rel_table)

    out = lax.map(one_block, jnp.arange(t // QUERY_BLOCK))
    return jnp.moveaxis(out, 0, 1).reshape(b, t, ATTN_WIDTH)


def nsa_sample(q, kv, gate, cache_kv_l, win_l, page_table, cmp_pe, cmp_w1, cmp_b1, cmp_w2, cmp_b2, rel_table):
    b, tn = q.shape[:2]
    n_pages = page_table.shape[1]
    past_len = n_pages * PAGE_SIZE
    past = cache_kv_l[page_table].reshape(b, past_len, N_CACHE_SLOTS, KV_HEADS, HEAD_DIM)
    full = jnp.concatenate([past, kv[:, :, :N_CACHE_SLOTS].astype(past.dtype)], 1)
    t_all = past_len + tn
    n_cmp = (t_all - CMP_BLOCK) // CMP_STRIDE + 1
    kc = compress(full[:, :, 0], cmp_pe[0], cmp_w1[0], cmp_b1[0], cmp_w2[0], cmp_b2[0], n_cmp)
    vc = compress(full[:, :, 1], cmp_pe[1], cmp_w1[1], cmp_b1[1], cmp_w2[1], cmp_b2[1], n_cmp)
    c_end = jnp.arange(n_cmp) * CMP_STRIDE + CMP_BLOCK - 1
    n_sel = -(-t_all // SEL_BLOCK)
    imp_map = overlap_map(n_cmp, n_sel)
    k_sel = pad_rows(full[:, :, 2], n_sel * SEL_BLOCK)
    v_sel = pad_rows(full[:, :, 3], n_sel * SEL_BLOCK)
    win_len = win_l.shape[1]
    win_all = jnp.concatenate([win_l, kv[:, :, N_CACHE_SLOTS:].astype(win_l.dtype)], 1)
    kw_pos = past_len - win_len + jnp.arange(win_len + tn)
    q_pos = past_len + jnp.arange(tn)
    o = nsa_block(q, gate, q_pos, kc, vc, c_end, imp_map, k_sel, v_sel,
                  win_all[:, :, 0], win_all[:, :, 1], kw_pos, rel_table)
    return o, win_all[:, -win_len:]


def ssd_scan(x, a, bm, cm, h0):
    b, t = x.shape[:2]
    q = min(SSD_CHUNK, t)
    n_ch = -(-t // q)
    pad = n_ch * q - t

    def chunks(v):
        v = jnp.pad(v, [(0, 0), (0, pad)] + [(0, 0)] * (v.ndim - 2))
        return jnp.moveaxis(v.reshape((b, n_ch, q) + v.shape[2:]), 1, 0)

    causal = jnp.tril(jnp.ones((q, q), bool))[None, :, :, None, None]

    def step(h, inp):
        xc, ac, bc, cc = inp
        acum = jnp.cumsum(ac, axis=1)
        seg = acum[:, :, None] - acum[:, None]
        decay = jnp.where(causal, jnp.exp(jnp.where(causal, seg, 0.0)), 0.0)
        cb = jnp.einsum('bign,bjgn->bijg', cc, bc)
        y = jnp.einsum('bijg,bijgr,bjgrp->bigrp', cb, decay, xc)
        y = y + jnp.einsum('bign,bgrpn->bigrp', cc, h) * jnp.exp(acum)[..., None]
        to_end = jnp.exp(acum[:, -1:] - acum)
        h = (h * jnp.exp(acum[:, -1])[..., None, None]
             + jnp.einsum('bjgn,bjgrp->bgrpn', bc, xc * to_end[..., None]))
        return h, y

    h_t, ys = lax.scan(step, h0, (chunks(x), chunks(a), chunks(bm), chunks(cm)))
    y = jnp.moveaxis(ys, 0, 1).reshape((b, n_ch * q) + x.shape[2:])[:, :t]
    return y, h_t


def ssd_mixer(z, xbc, dt_raw, conv_hist, h0, conv_w, conv_b, dt_bias, a_log, d_skip, norm_g):
    b, t = z.shape[:2]
    f32 = jnp.float32
    xbc_full = jnp.concatenate([conv_hist.astype(xbc.dtype), xbc], 1)
    xbc_c = jax.nn.silu(causal_dwconv(xbc_full, conv_w, conv_b))
    xs, bm, cm = jnp.split(xbc_c, [SSM_INNER, SSM_INNER + SSM_GROUPS * SSM_STATE], axis=-1)
    xs = xs.astype(f32).reshape(b, t, SSM_GROUPS, SSM_HPG, SSM_HEADDIM)
    bm = bm.astype(f32).reshape(b, t, SSM_GROUPS, SSM_STATE)
    cm = cm.astype(f32).reshape(b, t, SSM_GROUPS, SSM_STATE)
    dt = jax.nn.softplus(dt_raw.astype(f32) + dt_bias.astype(f32)).reshape(b, t, SSM_GROUPS, SSM_HPG)
    a = -jnp.exp(a_log.astype(f32)).reshape(SSM_GROUPS, SSM_HPG)
    h0g = h0.astype(f32).reshape(b, SSM_GROUPS, SSM_HPG, SSM_HEADDIM, SSM_STATE)
    y, h_t = ssd_scan(xs * dt[..., None], dt * a, bm, cm, h0g)
    y = y + xs * d_skip.astype(f32).reshape(SSM_GROUPS, SSM_HPG, 1)
    y = y.reshape(b, t, SSM_INNER) * jax.nn.silu(z.astype(f32))
    yg = y.reshape(b, t, SSM_GROUPS, SSM_INNER // SSM_GROUPS)
    yg = yg * lax.rsqrt(jnp.mean(yg * yg, -1, keepdims=True) + EPS)
    y = yg.reshape(b, t, SSM_INNER) * norm_g.astype(f32)
    new_h = h_t.reshape(b, SSM_HEADS, SSM_HEADDIM, SSM_STATE).astype(h0.dtype)
    return y.astype(z.dtype), xbc_full[:, -(SSM_CONV - 1):], new_h


def block_tail(x, attn, ssm, ffn_hist, w_out, g_mix_post, g_ffn_pre, w_gate, w_up, dw_w, dw_b, w_down, g_ffn_post):
    mix = jnp.concatenate([attn, ssm], -1) @ w_out
    x = x + rmsnorm(mix, g_mix_post)
    h = rmsnorm(x, g_ffn_pre)
    gp = h @ w_gate
    full = jnp.concatenate([ffn_hist.astype(gp.dtype), gp], 1)
    act = jax.nn.gelu(causal_dwconv(full, dw_w, dw_b), approximate=True) * (h @ w_up)
    x = x + rmsnorm(act @ w_down, g_ffn_post)
    return x, full[:, -(FFN_CONV - 1):]


def setup_inputs(seed: int = 0) -> dict:
    key = jax.random.key(seed)
    ks = iter(jax.random.split(key, 48))
    f32 = jnp.float32

    def nrm(shape, scale):
        return jax.random.normal(next(ks), shape, f32) * scale

    def gain(shape):
        return 1.0 + nrm(shape, 0.05)

    n_pages = PAST_LEN // PAGE_SIZE
    n_pool = (DEC_BATCH * n_pages * 5) // 4
    win_len = min(WINDOW, PAST_LEN)
    page_table = jax.random.permutation(next(ks), n_pool)[:DEC_BATCH * n_pages]
    page_table = page_table.reshape(DEC_BATCH, n_pages).astype(jnp.int32)
    dt0 = jnp.exp(jax.random.uniform(next(ks), (DEPTH, SSM_HEADS), f32, math.log(1e-3), math.log(1e-1)))
    dt_bias = dt0 + jnp.log(-jnp.expm1(-dt0))
    a_log = jnp.log(jax.random.uniform(next(ks), (DEPTH, SSM_HEADS), f32, 1.0, 16.0))
    return {
        'x_prompt': nrm((BATCH, SEQ, D_MODEL), 1.0),
        'x_sample': nrm((DEC_BATCH, DEC_SEQ, D_MODEL), 1.0),
        'cache_kv': nrm((DEPTH, n_pool, PAGE_SIZE, N_CACHE_SLOTS, KV_HEADS, HEAD_DIM), 1.0),
        'cache_win_kv': nrm((DEPTH, DEC_BATCH, win_len, 2, KV_HEADS, HEAD_DIM), 1.0),
        'state_ssm_conv': nrm((DEPTH, DEC_BATCH, SSM_CONV - 1, CONV_DIM), 1.0),
        'state_ssm': nrm((DEPTH, DEC_BATCH, SSM_HEADS, SSM_HEADDIM, SSM_STATE), 0.5),
        'state_ffn_conv': nrm((DEPTH, DEC_BATCH, FFN_CONV - 1, D_FF), 1.0),
        'page_table': page_table,
        'rel_table': nrm((REL_BUCKETS, N_HEADS), 0.5),
        'ln_mix_pre': gain((DEPTH, D_MODEL)),
        'w_in': nrm((DEPTH, D_MODEL, IN_WIDTH), D_MODEL ** -0.5),
        'cmp_pe': nrm((DEPTH, 2, CMP_BLOCK, HEAD_DIM), 0.1),
        'cmp_w1': nrm((DEPTH, 2, CMP_BLOCK, HEAD_DIM, CMP_HIDDEN), (CMP_BLOCK * HEAD_DIM) ** -0.5),
        'cmp_b1': nrm((DEPTH, 2, CMP_HIDDEN), 0.01),
        'cmp_w2': nrm((DEPTH, 2, CMP_HIDDEN, HEAD_DIM), CMP_HIDDEN ** -0.5),
        'cmp_b2': nrm((DEPTH, 2, HEAD_DIM), 0.01),
        'ssm_conv_w': nrm((DEPTH, SSM_CONV, CONV_DIM), SSM_CONV ** -0.5),
        'ssm_conv_b': nrm((DEPTH, CONV_DIM), 0.01),
        'ssm_dt_bias': dt_bias,
        'ssm_a_log': a_log,
        'ssm_d': gain((DEPTH, SSM_HEADS)),
        'ssm_norm_g': gain((DEPTH, SSM_INNER)),
        'w_out': nrm((DEPTH, MIX_WIDTH, D_MODEL), MIX_WIDTH ** -0.5),
        'ln_mix_post': gain((DEPTH, D_MODEL)),
        'ln_ffn_pre': gain((DEPTH, D_MODEL)),
        'ffn_w_gate': nrm((DEPTH, D_MODEL, D_FF), D_MODEL ** -0.5),
        'ffn_w_up': nrm((DEPTH, D_MODEL, D_FF), D_MODEL ** -0.5),
        'ffn_dw_w': nrm((DEPTH, FFN_CONV, D_FF), FFN_CONV ** -0.5),
        'ffn_dw_b': nrm((DEPTH, D_FF), 0.01),
        'ffn_w_down': nrm((DEPTH, D_FF, D_MODEL), D_FF ** -0.5),
        'ln_ffn_post': gain((DEPTH, D_MODEL)),
    }


def reference(x_prompt, x_sample, cache_kv, cache_win_kv, state_ssm_conv, state_ssm, state_ffn_conv,
              page_table, rel_table, ln_mix_pre, w_in, cmp_pe, cmp_w1, cmp_b1, cmp_w2, cmp_b2,
              ssm_conv_w, ssm_conv_b, ssm_dt_bias, ssm_a_log, ssm_d, ssm_norm_g, w_out, ln_mix_post,
              ln_ffn_pre, ffn_w_gate, ffn_w_up, ffn_dw_w, ffn_dw_b, ffn_w_down, ln_ffn_post):
    xp, xd = x_prompt, x_sample
    bp, tp = xp.shape[:2]
    kv_p, kv_d, win_p, win_d = [], [], [], []
    sc_p, sc_d, ss_p, ss_d, fc_p, fc_d = [], [], [], [], [], []
    for l in range(DEPTH):
        q, kv, gate, z, xbc, dt = project(xp, ln_mix_pre[l], w_in[l])
        attn = nsa_prompt(q, kv, gate, cmp_pe[l], cmp_w1[l], cmp_b1[l], cmp_w2[l], cmp_b2[l], rel_table)
        ssm, conv_new, h_new = ssd_mixer(
            z, xbc, dt, jnp.zeros((bp, SSM_CONV - 1, CONV_DIM), xp.dtype),
            jnp.zeros((bp, SSM_HEADS, SSM_HEADDIM, SSM_STATE), xp.dtype),
            ssm_conv_w[l], ssm_conv_b[l], ssm_dt_bias[l], ssm_a_log[l], ssm_d[l], ssm_norm_g[l])
        xp, ffn_new = block_tail(xp, attn, ssm, jnp.zeros((bp, FFN_CONV - 1, D_FF), xp.dtype),
                                 w_out[l], ln_mix_post[l], ln_ffn_pre[l], ffn_w_gate[l], ffn_w_up[l],
                                 ffn_dw_w[l], ffn_dw_b[l], ffn_w_down[l], ln_ffn_post[l])
        kv_p.append(kv[:, :, :N_CACHE_SLOTS])
        win_p.append(kv[:, tp - min(WINDOW, tp):, N_CACHE_SLOTS:])
        sc_p.append(conv_new)
        ss_p.append(h_new)
        fc_p.append(ffn_new)
        q, kv, gate, z, xbc, dt = project(xd, ln_mix_pre[l], w_in[l])
        attn, win_new = nsa_sample(q, kv, gate, cache_kv[l], cache_win_kv[l], page_table,
                                   cmp_pe[l], cmp_w1[l], cmp_b1[l], cmp_w2[l], cmp_b2[l], rel_table)
        ssm, conv_new, h_new = ssd_mixer(
            z, xbc, dt, state_ssm_conv[l], state_ssm[l],
            ssm_conv_w[l], ssm_conv_b[l], ssm_dt_bias[l], ssm_a_log[l], ssm_d[l], ssm_norm_g[l])
        xd, ffn_new = block_tail(xd, attn, ssm, state_ffn_conv[l],
                                 w_out[l], ln_mix_post[l], ln_ffn_pre[l], ffn_w_gate[l], ffn_w_up[l],
                                 ffn_dw_w[l], ffn_dw_b[l], ffn_w_down[l], ln_ffn_post[l])
        kv_d.append(kv[:, :, :N_CACHE_SLOTS])
        win_d.append(win_new)
        sc_d.append(conv_new)
        ss_d.append(h_new)
        fc_d.append(ffn_new)
    new_kv_p = jnp.stack(kv_p)
    new_kv_d = jnp.stack(kv_d)
    new_win_p = jnp.stack(win_p)
    new_win_d = jnp.stack(win_d)
    new_conv_p = jnp.stack(sc_p)
    new_conv_d = jnp.stack(sc_d)
    new_ssm_p = jnp.stack(ss_p)
    new_ssm_d = jnp.stack(ss_d)
    new_ffn_p = jnp.stack(fc_p)
    new_ffn_d = jnp.stack(fc_d)
    return (xp, xd, new_kv_p, new_kv_d, new_win_p, new_win_d, new_conv_p, new_conv_d,
            new_ssm_p, new_ssm_d, new_ffn_p, new_ffn_d)
```

```cpp
#include <hip/hip_runtime.h>
#include <cstdio>
#include <cstdint>
#ifndef MK_ONE_LAUNCH
#define MK_ONE_LAUNCH 1
#endif
namespace pg8 {
#define PG8_LAS __attribute__((address_space(3)))
typedef unsigned short bf16_t;
typedef short bf16x8 __attribute__((ext_vector_type(8)));
typedef float f32x4 __attribute__((ext_vector_type(4)));
typedef unsigned u32x4 __attribute__((ext_vector_type(4)));
constexpr int BM = 256, BK = 64, HALF = 128, HTB = HALF * BK * 2  , STAGE_BYTES = 8 * HTB, NXCD = 8, WGM = 8;

__host__ __device__ __forceinline__ int lds_byte(int r, int c) { const int st = (r >> 4) * 2 + (c >> 5), rr = r & 15, cc = c & 31, ob = rr * 64 + cc * 2; return st * 1024 + (ob ^ (((ob >> 9) & 1) << 5)); }
__host__ __device__ __forceinline__ void stage_rc(int b, int& R, int& C) { const int st = b / 1024, sb = b % 1024, swz = sb ^ (((sb >> 9) & 1) << 5); R = (st >> 1) * 16 + swz / 64; C = (st & 1) * 32 + (swz % 64) / 2; }
__host__ __device__ __forceinline__ int perm32(int rho) { const int n = rho >> 4, i = rho & 15; return 8 * (i >> 2) + 4 * n + (i & 3); }

struct Unit { int pm, pn; };
struct Gemm { const bf16_t* A; const bf16_t* Bt; int M, N, K; };

struct StaticOrder {
    int nM, nN, nwg, G, c;
    __host__ __device__ void init(int M, int N, int G_, int c_) { nM = M / BM; nN = N / BM; nwg = nM * nN; G = G_; c = c_; }
    __host__ __device__ bool next(int i, Unit& u) const {
        const long L = (long)i * G + c; if (L >= nwg) return false;
        int wgid = (int)L; { const int q = nwg / NXCD, r = nwg % NXCD, xcd = wgid % NXCD, off = wgid / NXCD; wgid = (xcd < r ? xcd * (q + 1) : r * (q + 1) + (xcd - r) * q) + off; }
        const int nig = WGM * nN, gid = wgid / nig, fm = gid * WGM, gsz = (nM - fm) < WGM ? (nM - fm) : WGM;
        u.pm = fm + ((wgid % nig) % gsz); u.pn = (wgid % nig) / gsz; return true;
    }
    __device__ __forceinline__ void a_ready(const Unit&) const {}
    __device__ __forceinline__ void done(const Unit&) const {}
};

template <class Epi, class Sched, bool ALIGN_EPI = false, bool SP2 = false>
__device__ __forceinline__ void gemm_phase(PG8_LAS unsigned char* lds, const Gemm g, const Sched& S, const Epi& E) {
    const int tid = threadIdx.x, wid = __builtin_amdgcn_readfirstlane(tid >> 6), lane = tid & 63, wr = wid >> 2, wc = wid & 3, fr = lane & 15, fq = lane >> 4;
    const int K = g.K, nt = K / BK;
    unsigned voffA[2], voffB[2];
#pragma unroll
    for (int i = 0; i < 2; ++i) { int R, C; stage_rc(tid * 16 + i * 8192, R, C); const int Rb = Epi::PERM ? ((R & ~31) + perm32(R & 31)) : R;
        voffA[i] = (unsigned)(R * K + C) * 2u; voffB[i] = (unsigned)(Rb * K + C) * 2u; }
    const size_t kstep = (size_t)(BK * 2);
    const size_t hstep = (size_t)HALF * K * 2;
    const size_t tstep = 2 * hstep;
    const unsigned ldsw = (unsigned)wid * 1024u;
    const int aoff = lds_byte(wr * 64 + fr, fq * 8), boff = lds_byte(wc * 32 + fr, fq * 8);
#define PG8_SA(b, h) (((b) * 2 + (h)) * HTB)
#define PG8_SB(b, h) ((4 + (b) * 2 + (h)) * HTB)
#define PG8_STAGE(bufoff, gbase, voff) do { _Pragma("unroll") for (int _i = 0; _i < 2; ++_i) \
        __builtin_amdgcn_global_load_lds((const unsigned*)((const char*)(gbase) + (voff)[_i]), (PG8_LAS unsigned*)(lds + (bufoff) + ldsw + _i * 8192), 16, 0, 0); } while (0)
#define PG8_LDA(dst, b, h) do { _Pragma("unroll") for (int m = 0; m < 4; ++m) _Pragma("unroll") for (int k = 0; k < 2; ++k) dst[m][k] = *(const PG8_LAS bf16x8*)(lds + PG8_SA(b, h) + aoff + m * 2048 + k * 1024); } while (0)
#define PG8_LDB(dst, b, h) do { _Pragma("unroll") for (int n = 0; n < 2; ++n) _Pragma("unroll") for (int k = 0; k < 2; ++k) dst[n][k] = *(const PG8_LAS bf16x8*)(lds + PG8_SB(b, h) + boff + n * 2048 + k * 1024); } while (0)
#define PG8_MMA(ai, bj, At, Bt) do { __builtin_amdgcn_s_setprio(1); _Pragma("unroll") for (int m = 0; m < 4; ++m) _Pragma("unroll") for (int n = 0; n < 2; ++n) _Pragma("unroll") for (int k = 0; k < 2; ++k) \
        acc[ai][bj][m][n] = __builtin_amdgcn_mfma_f32_16x16x32_bf16(Bt[n][k], At[m][k], acc[ai][bj][m][n], 0, 0, 0); __builtin_amdgcn_s_setprio(0); } while (0)
#define PG8_WAIT_V(n) asm volatile("s_waitcnt vmcnt(" #n ")" ::: "memory")
#define PG8_WAIT_L(n) asm volatile("s_waitcnt lgkmcnt(" #n ")" ::: "memory")
#define PG8_BAR __builtin_amdgcn_s_barrier()
#define PG8_SCHED __builtin_amdgcn_sched_barrier(0)
    Unit cur, nxt; int ui = 0;
    if (!S.next(0, cur)) return;
    f32x4 acc[2][2][4][2];
#pragma unroll
    for (int a = 0; a < 2; ++a)
#pragma unroll
        for (int b = 0; b < 2; ++b)
#pragma unroll
            for (int m = 0; m < 4; ++m)
#pragma unroll
                for (int n = 0; n < 2; ++n) acc[a][b][m][n] = (f32x4){0.f, 0.f, 0.f, 0.f};
    bf16x8 At[4][2], B0[2][2], B1[2][2];
    const char* cA = (const char*)g.A + (size_t)cur.pm * tstep; const char* cB = (const char*)g.Bt + (size_t)cur.pn * tstep;
    S.a_ready(cur);
    if constexpr (SP2) {
        PG8_STAGE(PG8_SB(0, 0), cB, voffB); PG8_STAGE(PG8_SB(0, 1), cB + hstep, voffB); PG8_STAGE(PG8_SA(0, 0), cA, voffA); PG8_STAGE(PG8_SA(0, 1), cA + hstep, voffA);
        if (wr == 1) PG8_BAR;
        PG8_WAIT_V(2); PG8_BAR;
        PG8_STAGE(PG8_SB(1, 0), cB + kstep, voffB); PG8_STAGE(PG8_SA(1, 0), cA + kstep, voffA); PG8_STAGE(PG8_SB(1, 1), cB + hstep + kstep, voffB);
        PG8_WAIT_V(6); PG8_BAR;
    } else {
        PG8_STAGE(PG8_SB(0, 0), cB, voffB); PG8_STAGE(PG8_SA(0, 0), cA, voffA); PG8_STAGE(PG8_SB(0, 1), cB + hstep, voffB); PG8_STAGE(PG8_SA(0, 1), cA + hstep, voffA);
        if (wr == 1) PG8_BAR;
        PG8_WAIT_V(4); PG8_BAR;
        PG8_STAGE(PG8_SB(1, 0), cB + kstep, voffB); PG8_STAGE(PG8_SA(1, 0), cA + kstep, voffA); PG8_STAGE(PG8_SB(1, 1), cB + hstep + kstep, voffB);
        PG8_WAIT_V(6); PG8_BAR;
    }
    for (;;) {
        const bool has_next = S.next(ui + 1, nxt);
        const char* nA = has_next ? (const char*)g.A + (size_t)nxt.pm * tstep : cA; const char* nB = has_next ? (const char*)g.Bt + (size_t)nxt.pn * tstep : cB;
        for (int t = 0; t < nt; t += 2) {
            const bool last = (t == nt - 2);
            const char* a1 = cA + (size_t)(t + 1) * kstep;
            const char* a2 = last ? nA : cA + (size_t)(t + 2) * kstep; const char* b2 = last ? nB : cB + (size_t)(t + 2) * kstep;
            const char* a3 = a2 + kstep; const char* b3 = b2 + kstep;
            if (last && has_next) S.a_ready(nxt);
            if constexpr (SP2) {
            PG8_LDB(B0, 0, 0); PG8_LDB(B1, 0, 1); PG8_SCHED; PG8_LDA(At, 0, 0); PG8_STAGE(PG8_SA(1, 1), a1 + hstep, voffA);
            PG8_WAIT_V(8); PG8_WAIT_L(0); PG8_BAR; PG8_MMA(0, 0, At, B0); PG8_MMA(0, 1, At, B1); PG8_BAR; PG8_SCHED;
            PG8_LDA(At, 0, 1); PG8_STAGE(PG8_SB(0, 0), b2, voffB); PG8_STAGE(PG8_SB(0, 1), b2 + hstep, voffB); PG8_STAGE(PG8_SA(0, 0), a2, voffA);
            PG8_WAIT_V(8); PG8_WAIT_L(0); PG8_BAR; PG8_MMA(1, 0, At, B0); PG8_MMA(1, 1, At, B1); PG8_BAR; PG8_SCHED;
            PG8_LDB(B0, 1, 0); PG8_LDB(B1, 1, 1); PG8_SCHED; PG8_LDA(At, 1, 0); PG8_STAGE(PG8_SA(0, 1), a2 + hstep, voffA);
            PG8_WAIT_V(8); PG8_WAIT_L(0); PG8_BAR; PG8_MMA(0, 0, At, B0); PG8_MMA(0, 1, At, B1); PG8_BAR; PG8_SCHED;
            PG8_LDA(At, 1, 1); PG8_STAGE(PG8_SB(1, 0), b3, voffB); PG8_STAGE(PG8_SB(1, 1), b3 + hstep, voffB); PG8_STAGE(PG8_SA(1, 0), a3, voffA);
            PG8_WAIT_V(8); PG8_WAIT_L(0); PG8_BAR; PG8_MMA(1, 0, At, B0); PG8_MMA(1, 1, At, B1); PG8_BAR; PG8_SCHED;
            } else {
            PG8_LDB(B0, 0, 0); PG8_SCHED; PG8_LDA(At, 0, 0); PG8_STAGE(PG8_SA(1, 1), a1 + hstep, voffA);
            PG8_WAIT_L(8); PG8_BAR; PG8_WAIT_L(0); PG8_MMA(0, 0, At, B0); PG8_BAR; PG8_SCHED;
            PG8_LDB(B1, 0, 1); PG8_STAGE(PG8_SB(0, 0), b2, voffB);
            PG8_BAR; PG8_WAIT_L(0); PG8_MMA(0, 1, At, B1); PG8_BAR;
            PG8_LDA(At, 0, 1); PG8_STAGE(PG8_SA(0, 0), a2, voffA);
            PG8_BAR; PG8_WAIT_L(0); PG8_MMA(1, 0, At, B0); PG8_BAR; PG8_SCHED;
            PG8_STAGE(PG8_SB(0, 1), b2 + hstep, voffB);
            PG8_WAIT_V(6); PG8_BAR; PG8_MMA(1, 1, At, B1); PG8_BAR;
            PG8_LDB(B0, 1, 0); PG8_SCHED; PG8_LDA(At, 1, 0); PG8_STAGE(PG8_SA(0, 1), a2 + hstep, voffA);
            PG8_WAIT_L(8); PG8_BAR; PG8_WAIT_L(0); PG8_MMA(0, 0, At, B0); PG8_BAR; PG8_SCHED;
            PG8_LDB(B1, 1, 1); PG8_STAGE(PG8_SB(1, 0), b3, voffB);
            PG8_BAR; PG8_WAIT_L(0); PG8_MMA(0, 1, At, B1); PG8_BAR;
            PG8_LDA(At, 1, 1); PG8_STAGE(PG8_SA(1, 0), a3, voffA);
            PG8_BAR; PG8_WAIT_L(0); PG8_MMA(1, 0, At, B0); PG8_BAR; PG8_SCHED;
            PG8_STAGE(PG8_SB(1, 1), b3 + hstep, voffB);
            PG8_WAIT_V(6); PG8_BAR; PG8_MMA(1, 1, At, B1); PG8_BAR;
            }
        }
        if constexpr (ALIGN_EPI) { if (wr == 0) PG8_BAR; }
        if constexpr (!Epi::AFTER_DRAIN) { E(acc, cur, wr, wc, fr, fq); S.done(cur); }
        if (!has_next) break;
#pragma unroll
        for (int a = 0; a < 2; ++a)
#pragma unroll
            for (int b = 0; b < 2; ++b)
#pragma unroll
                for (int m = 0; m < 4; ++m)
#pragma unroll
                    for (int n = 0; n < 2; ++n) acc[a][b][m][n] = (f32x4){0.f, 0.f, 0.f, 0.f};
        cur = nxt; cA = nA; cB = nB; ++ui;
        if constexpr (ALIGN_EPI) { if (wr == 1) PG8_BAR; }
    }
    PG8_WAIT_V(0);
    if constexpr (!ALIGN_EPI) { if (wr == 0) PG8_BAR; }
    PG8_BAR;
    if constexpr (Epi::AFTER_DRAIN) { E.fused(acc, cur, wr, wc, fr, fq, lds, wid, lane); S.done(cur); }
#undef PG8_SA
#undef PG8_SB
#undef PG8_STAGE
#undef PG8_LDA
#undef PG8_LDB
#undef PG8_MMA
#undef PG8_WAIT_V
#undef PG8_WAIT_L
#undef PG8_BAR
#undef PG8_SCHED
}
}

#define LAS __attribute__((address_space(3)))
#define DI __device__ __forceinline__
typedef unsigned short bf16;
typedef short bf16x8 __attribute__((ext_vector_type(8)));
typedef short s16x4 __attribute__((ext_vector_type(4)));
typedef float f32x4 __attribute__((ext_vector_type(4)));
typedef float f32x2 __attribute__((ext_vector_type(2)));
typedef float f32x16 __attribute__((ext_vector_type(16)));
typedef unsigned u32x4 __attribute__((ext_vector_type(4)));
typedef unsigned u32x2 __attribute__((ext_vector_type(2)));
typedef __bf16 bf16x2_t __attribute__((ext_vector_type(2)));

constexpr int NWAVES = 8, NTHR = 512;
constexpr int DM = 2048, BP = 4, TP = 2048, BS = 128, TS = 8, MP = BP * TP, MS = BS * TS, MT = MP + MS;
constexpr int NPROJ = 5888, DFF = 5504, DFFP = 5632, INW = 5696;
constexpr int NUNIT = 16 + 512;
constexpr float EPS = 1e-6f, NEGF = -1e30f, TINYF = 1e-30f;
enum { I_XP = 0, I_XS, I_CKV, I_CWIN, I_SCONV, I_SSM, I_FCONV, I_PT, I_REL, I_LNPRE, I_WIN, I_CPE, I_CW1, I_CB1, I_CW2, I_CB2, I_SCW, I_SCB, I_DTB, I_ALOG, I_SD, I_SNG,
       I_WOUT, I_LNPOST, I_LNFPRE, I_WG, I_WU, I_DWW, I_DWB, I_WD, I_LNFPOST, N_IN };
constexpr size_t O_YP = 0, O_YS = 16777216, O_KVP = 18874368, O_KVS = 27262976, O_WINP = 28311552, O_WINS = 29360128, O_SCP = 62914560, O_SCS = 62939136,
                 O_SSP = 63725568, O_SSS = 64249856, O_FCP = 81027072, O_FCS = 81071104, O_END = 82480128;
constexpr size_t MiB = 1u << 20;
constexpr size_t WS_CTL = 0, CTL_ZERO_BYTES = 1 * MiB;
constexpr size_t WS_WIN = 2 * MiB, WS_WOUT = 26 * MiB, WS_WG = 34 * MiB, WS_WU = 56 * MiB, WS_WD = 78 * MiB, WS_W12 = 100 * MiB;
constexpr size_t WS_W2T = 101 * MiB, WS_CBP = 101 * MiB + 65536, WS_LUT = 101 * MiB + 131072;
constexpr size_t WS_XN = 102 * MiB, WS_QB = 138 * MiB, WS_KB = 156 * MiB, WS_VT = 164 * MiB, WS_ZF = 172 * MiB, WS_XBC = 208 * MiB;
constexpr size_t WS_GATE = 280 * MiB, WS_DTR = 282 * MiB, WS_XBCC = 284 * MiB, WS_DT = 356 * MiB, WS_KCK = 358 * MiB, WS_KCVT = 368 * MiB;
constexpr size_t WS_YSSM = 378 * MiB, WS_MIX = 414 * MiB, WS_MIXO = 450 * MiB, WS_X1 = 522 * MiB, WS_GP = 594 * MiB, WS_ACT = 694 * MiB, WS_FFN = 794 * MiB, WS_END = 868 * MiB;
constexpr int CW_BAR = 4096;
constexpr int RING_BYTES = 131072, LDSCTL_OFF = RING_BYTES, MISC_OFF = LDSCTL_OFF + 320, LUT_OFF = RING_BYTES + 1024, LDS_BYTES = 147456;
static_assert(LUT_OFF + 8192 <= LDS_BYTES, "LDS map");

DI unsigned pk2(float lo, float hi) { f32x2 v = {lo, hi}; bf16x2_t b = __builtin_convertvector(v, bf16x2_t); return __builtin_bit_cast(unsigned, b); }
DI bf16x8 cvt8(f32x4 a, f32x4 b) { u32x4 p = {pk2(a.x, a.y), pk2(a.z, a.w), pk2(b.x, b.y), pk2(b.z, b.w)}; return __builtin_bit_cast(bf16x8, p); }
DI float bf2f(unsigned short u) { return __uint_as_float(((unsigned)u) << 16); }
DI float sigmoidf_(float x) { return 1.0f / (1.0f + __expf(-x)); }
DI float siluf_(float x) { return x * sigmoidf_(x); }
DI float gelu_tanh(float x) { const float u = 0.7978845608028654f * (x + 0.044715f * x * x * x); const float e = __expf(2.0f * u); const float th = 1.0f - 2.0f / (e + 1.0f); return 0.5f * x * (1.0f + th); }
DI float softplusf_(float x) { return x > 20.f ? x : log1pf(__expf(x)); }
DI int crow(int reg, int h) { return (reg & 3) + 8 * (reg >> 2) + 4 * h; }
DI float wave_sum(float v) {
#pragma unroll
    for (int o = 1; o < 64; o <<= 1) v += __shfl_xor(v, o);
    return v;
}
#define MFMA32(a, b, c) __builtin_amdgcn_mfma_f32_32x32x16_bf16((a), (b), (c), 0, 0, 0)
#define VM_WAIT() asm volatile("s_waitcnt vmcnt(0)" ::: "memory")
#define LDS_WAIT() asm volatile("s_waitcnt lgkmcnt(0)" ::: "memory")

struct Frame {
    LAS unsigned char* lds;
    int tid, lane, wave, vcu, G;
    const float* in[N_IN]; const int* pt;
    float* out; unsigned char* ws;
};
template <class T> DI T* wsp(const Frame& F, size_t off) { return (T*)(F.ws + off); }

template <int MAP> DI int rowmap(int n) {
    if (MAP == 0) return n;
    if (n < 2560) return n;
    if (n < 2608) return 5632 + (n - 2560);
    if (n < 3632) return 2560 + (n - 2608);
    if (n < 5680) return 3584 + (n - 3632);
    return 5632 + 48 + (n - 5680);
}
template <int MAP> DI void transpose_item(const float* W, int N, bf16* WT, int dst_pitch, int row_off, LAS float* scr, int item, int lane) {
    const int nblk = N / 32, kb = item / nblk, nb = item % nblk, k0 = 64 * kb, n0 = 32 * nb;
#pragma unroll 8
    for (int i = 0; i < 32; ++i) { const int kk = 2 * i + (lane >> 5); scr[kk * 33 + (lane & 31)] = W[(size_t)(k0 + kk) * N + n0 + (lane & 31)]; }
    LDS_WAIT(); asm volatile("" ::: "memory");
    const int c = lane & 7;
#pragma unroll
    for (int j = 0; j < 4; ++j) { const int n = (lane >> 3) + 8 * j; const LAS float* s = scr + (8 * c) * 33 + n;
        u32x4 o; o.x = pk2(s[0 * 33], s[1 * 33]); o.y = pk2(s[2 * 33], s[3 * 33]); o.z = pk2(s[4 * 33], s[5 * 33]); o.w = pk2(s[6 * 33], s[7 * 33]);
        *(u32x4*)(WT + (size_t)(row_off + rowmap<MAP>(n0 + n)) * dst_pitch + k0 + 8 * c) = o; }
    LDS_WAIT(); asm volatile("" ::: "memory");
}
DI void rmsnorm_row_bf16(const float* xrow, const float* g, bf16* orow, int lane) {
    const f32x4* xr = (const f32x4*)xrow + lane; const f32x4* gr = (const f32x4*)g + lane;
    f32x4 v[8]; float s = 0.f;
#pragma unroll
    for (int j = 0; j < 8; ++j) { v[j] = xr[64 * j]; s += (v[j].x * v[j].x + v[j].y * v[j].y) + (v[j].z * v[j].z + v[j].w * v[j].w); }
    const float rs = 1.0f / sqrtf(wave_sum(s) * (1.f / DM) + EPS);
    u32x2* o8 = (u32x2*)orow + lane;
#pragma unroll
    for (int j = 0; j < 8; ++j) { const f32x4 gg = gr[64 * j]; u32x2 w; w.x = pk2(v[j].x * rs * gg.x, v[j].y * rs * gg.y); w.y = pk2(v[j].z * rs * gg.z, v[j].w * rs * gg.w); o8[64 * j] = w; }
}
DI int rel_bucket(int n) {
    if (n < 16) return n;
    const int v = 16 + (int)(logf((float)n * (1.0f / 16.0f)) * (16.0f / 2.0794415416798357f));
    return v < 31 ? v : 31;
}
DI void ph0_prologue(Frame& F) {
    LAS float* scr = (LAS float*)(F.lds + F.wave * 16384);
    const int gw = F.vcu * NWAVES + F.wave, NGW = F.G * NWAVES, lane = F.lane;
    bf16* WINT = wsp<bf16>(F, WS_WIN); bf16* WOUTT = wsp<bf16>(F, WS_WOUT); bf16* WGT = wsp<bf16>(F, WS_WG); bf16* WUT = wsp<bf16>(F, WS_WU); bf16* WDT = wsp<bf16>(F, WS_WD);
    bf16* W12T = wsp<bf16>(F, WS_W12); bf16* W2T = wsp<bf16>(F, WS_W2T);
    constexpr int I_IN = (DM / 64) * (INW / 32), I_OUT = (DM / 64) * (DM / 32), I_G = (DM / 64) * (DFF / 32), I_D = (DFF / 64) * (DM / 32), I_12 = (1024 / 64) * (128 / 32), I_2 = (128 / 64) * (64 / 32);
    constexpr int NITEMS = I_IN + I_OUT + 2 * I_G + I_D + 4 * I_12 + 2 * I_2;
    for (int it = gw; it < NITEMS; it += NGW) {
        int r = it;
        if (r < I_IN) { transpose_item<1>(F.in[I_WIN], INW, WINT, DM, 0, scr, r, lane); continue; } r -= I_IN;
        if (r < I_OUT) { transpose_item<0>(F.in[I_WOUT], DM, WOUTT, DM, 0, scr, r, lane); continue; } r -= I_OUT;
        if (r < I_G) { transpose_item<0>(F.in[I_WG], DFF, WGT, DM, 0, scr, r, lane); continue; } r -= I_G;
        if (r < I_G) { transpose_item<0>(F.in[I_WU], DFF, WUT, DM, 0, scr, r, lane); continue; } r -= I_G;
        if (r < I_D) { transpose_item<0>(F.in[I_WD], DM, WDT, DFFP, 0, scr, r, lane); continue; } r -= I_D;
        if (r < 4 * I_12) { const int q = r / I_12, kv = q >> 1, hf = q & 1;
            transpose_item<0>(F.in[I_CW1] + (size_t)kv * 2048 * 128 + (size_t)hf * 1024 * 128, 128, W12T + (size_t)kv * 256 * 1024, 1024, hf * 128, scr, r % I_12, lane); continue; } r -= 4 * I_12;
        { const int kv = r / I_2; transpose_item<0>(F.in[I_CW2] + (size_t)kv * 128 * 64, 64, W2T + (size_t)kv * 64 * 128, 128, 0, scr, r % I_2, lane); }
    }
    {
        const int gt = F.vcu * NTHR + F.tid, NGT = F.G * NTHR; const u32x4 z = {0u, 0u, 0u, 0u};
        for (int i = gt; i < 192 * 256; i += NGT) ((u32x4*)(WINT + (size_t)5696 * DM))[i] = z;
        for (int i = gt; i < 128 * 256; i += NGT) { ((u32x4*)(WGT + (size_t)DFF * DM))[i] = z; ((u32x4*)(WUT + (size_t)DFF * DM))[i] = z; }
        for (int i = gt; i < 2048 * 16; i += NGT) { const int row = i >> 4, c = i & 15; *(u32x4*)(WDT + (size_t)row * DFFP + DFF + 8 * c) = z; }
        float* LUT = wsp<float>(F, WS_LUT);
        for (int i = gt; i < 2048; i += NGT) { const int dist = i >> 4, hd = i & 15; LUT[i] = F.in[I_REL][rel_bucket(dist) * 16 + hd]; }
        const f32x4* src = (const f32x4*)F.in[I_CWIN]; f32x4* dst = (f32x4*)(F.out + O_WINS);
        for (int i = gt; i < BS * 504 * 128; i += NGT) { const int b = i / (504 * 128), rr = i % (504 * 128); dst[(size_t)b * 512 * 128 + rr] = src[(size_t)b * 512 * 128 + 8 * 128 + rr]; }
    }
    {
        float* CBP = wsp<float>(F, WS_CBP);
        for (int it = gw; it < 32; it += NGW) { const int kv = it >> 4, part = (it >> 1) & 7, hh = (it & 1) * 64 + lane;
            const float* pe = F.in[I_CPE] + (size_t)kv * 2048; const float* w1 = F.in[I_CW1] + (size_t)kv * 2048 * 128; float s = 0.f;
#pragma unroll 8
            for (int k = part * 256; k < part * 256 + 256; ++k) s += pe[k] * w1[(size_t)k * 128 + hh];
            CBP[(kv * 8 + part) * 128 + hh] = s; }
    }
    bf16* XN = wsp<bf16>(F, WS_XN);
    for (int m = gw; m < MT; m += NGW) { const float* xr = m < MP ? F.in[I_XP] + (size_t)m * DM : F.in[I_XS] + (size_t)(m - MP) * DM; rmsnorm_row_bf16(xr, F.in[I_LNPRE], XN + (size_t)m * DM, lane); }
}
#define XB_TMO      128
#define XB_XCNT(j)  (256  + 64 * (j))
#define XB_XSUB(j)  (1280 + 64 * (j))
#define XB_XGEN(j)  (2304 + 64 * (j))
#define XB_TOP      3328
#define XB_TOPGEN   3392
#define XCD_BAR_WORDS 3456
#define XB_SPIN_CAP (1u << 18)

__device__ __forceinline__ unsigned xb_ld(unsigned* p)              { return __hip_atomic_load(p, __ATOMIC_RELAXED, __HIP_MEMORY_SCOPE_AGENT); }
__device__ __forceinline__ unsigned xb_add(unsigned* p, unsigned v) { return __hip_atomic_fetch_add(p, v, __ATOMIC_RELAXED, __HIP_MEMORY_SCOPE_AGENT); }
__device__ __forceinline__ unsigned xb_xcc_id() { return (unsigned)__builtin_amdgcn_s_getreg((3 << 11) | 20) & 0xFu; }
#define XB_SPIN(cond, bar) do { unsigned _sp = 0; while (cond) { __builtin_amdgcn_s_sleep(1); \
    if ((++_sp & 255u) == 0u) { if (xb_ld(&(bar)[XB_TMO])) break; if (_sp > XB_SPIN_CAP) { atomicAdd(&(bar)[XB_TMO], 1u); break; } } } } while (0)

struct XcdBarrier {
    unsigned* bar; unsigned x;
    volatile LAS unsigned* st;
};

__device__ __forceinline__ XcdBarrier xcd_barrier_post(unsigned* bar, volatile LAS unsigned* st) {
    XcdBarrier b; b.bar = bar; b.x = xb_xcc_id(); b.st = st;
    if (threadIdx.x == 0) (void)xb_add(&bar[XB_XCNT(b.x)], 1u);
    return b;
}
__device__ __forceinline__ void xcd_barrier_complete(unsigned* bar, unsigned x, unsigned& nloc, unsigned& nx) {
    const unsigned G = gridDim.x * gridDim.y * gridDim.z;
    unsigned sum, cnt, mine, sp = 0u;
    for (;;) {
        sum = 0u; cnt = 0u; mine = 0u;
#pragma unroll
        for (unsigned j = 0; j < 16; ++j) { const unsigned c = xb_ld(&bar[XB_XCNT(j)]); sum += c; cnt += (c > 0u) ? 1u : 0u; mine = (j == x) ? c : mine; }
        if (sum == G) break;
        __builtin_amdgcn_s_sleep(1);
        if ((++sp & 255u) == 0u) { if (xb_ld(&bar[XB_TMO])) break; if (sp > XB_SPIN_CAP) { atomicAdd(&bar[XB_TMO], 1u); break; } }
    }
    nloc = mine > 0u ? mine : 1u; nx = cnt > 0u ? cnt : 1u;
}

__device__ __forceinline__ void xcd_barrier(const XcdBarrier& b) {
    asm volatile("s_waitcnt vmcnt(0)" ::: "memory");
    __syncthreads();
    if (threadIdx.x == 0) {
        unsigned* bar = b.bar;
        __builtin_amdgcn_s_waitcnt(0);
        unsigned nloc = b.st[0], nx = b.st[1];
        if (nloc == 0u) { xcd_barrier_complete(bar, b.x, nloc, nx); b.st[0] = nloc; b.st[1] = nx; }
        const unsigned old = xb_add(&bar[XB_XSUB(b.x)], 1u);
        const unsigned gen = old / nloc;
        if (old + 1u == (gen + 1u) * nloc) {
            __builtin_amdgcn_fence(__ATOMIC_RELEASE, "agent");
            asm volatile("s_waitcnt vmcnt(0)" ::: "memory");
            const unsigned og = xb_add(&bar[XB_TOP], 1u);
            const unsigned tg = og / nx;
            if (og + 1u == (tg + 1u) * nx) xb_add(&bar[XB_TOPGEN], 1u);
            else XB_SPIN(xb_ld(&bar[XB_TOPGEN]) == tg, bar);
            __builtin_amdgcn_fence(__ATOMIC_ACQUIRE, "agent");
            xb_add(&bar[XB_XGEN(b.x)], 1u);
            asm volatile("s_waitcnt vmcnt(0)" ::: "memory");
        } else {
            XB_SPIN(xb_ld(&bar[XB_XGEN(b.x)]) == gen, bar);
            __builtin_amdgcn_fence(__ATOMIC_ACQUIRE, "agent");
            asm volatile("s_waitcnt vmcnt(0)" ::: "memory");
        }
    }
    __syncthreads();
}

struct EpiProj {
    static constexpr bool PERM = false, AFTER_DRAIN = false;
    bf16* QB; float* out; bf16* KB; bf16* VT; float* ZF; float* XBC; float* GATE; float* DTR;
    __device__ __forceinline__ void operator()(const pg8::f32x4 (&acc)[2][2][4][2], const pg8::Unit& u, int wr, int wc, int fr, int fq) const {
        const int pn = u.pn;
#pragma unroll
        for (int ai = 0; ai < 2; ++ai)
#pragma unroll
            for (int m = 0; m < 4; ++m) {
                const int row = u.pm * 256 + ai * 128 + wr * 64 + m * 16 + fr;
                const bool isp = row < MP; const int b = isp ? (row >> 11) : ((row - MP) >> 3); const int t = isp ? (row & 2047) : ((row - MP) & 7);
#pragma unroll
                for (int bj = 0; bj < 2; ++bj)
#pragma unroll
                    for (int n = 0; n < 2; ++n) {
                        const int cl = bj * 128 + wc * 32 + n * 16 + fq * 4; const f32x4 v = acc[ai][bj][m][n];
                        if (pn < 4) { u32x2 w; w.x = pk2(v.x, v.y); w.y = pk2(v.z, v.w); *(u32x2*)(QB + (size_t)row * 1024 + pn * 256 + cl) = w; }
                        else if (pn < 10) { const int slot = pn - 4, g = cl >> 6, d = cl & 63;
                            if (slot < 4) { float* dst = isp ? out + O_KVP + ((size_t)row * 4 + slot) * 256 + cl : out + O_KVS + ((size_t)(row - MP) * 4 + slot) * 256 + cl; *(f32x4*)dst = v; }
                            else { const int s2 = slot - 4;
                                if (isp) { if (t >= TP - 512) *(f32x4*)(out + O_WINP + (((size_t)b * 512 + (t - (TP - 512))) * 2 + s2) * 256 + cl) = v; }
                                else *(f32x4*)(out + O_WINS + (((size_t)b * 512 + 504 + t) * 2 + s2) * 256 + cl) = v; }
                            if (isp && slot >= 2) { const int sl = slot >> 2;
                                if ((slot & 1) == 0) { u32x2 w; w.x = pk2(v.x, v.y); w.y = pk2(v.z, v.w); *(u32x2*)(KB + ((size_t)((b * 2 + sl) * 4 + g) * 2048 + t) * 64 + d) = w; }
                                else { bf16* vp = VT + ((size_t)((b * 2 + sl) * 4 + g) * 64 + d) * 2048 + t; const unsigned p0 = pk2(v.x, v.y), p1 = pk2(v.z, v.w);
                                    vp[0] = (bf16)(p0 & 0xffffu); vp[2048] = (bf16)(p0 >> 16); vp[4096] = (bf16)(p1 & 0xffffu); vp[6144] = (bf16)(p1 >> 16); } } }
                        else if (pn < 14) *(f32x4*)(ZF + (size_t)row * 1024 + (pn - 10) * 256 + cl) = v;
                        else if (pn < 22) *(f32x4*)(XBC + (size_t)row * 2048 + (pn - 14) * 256 + cl) = v;
                        else { if (cl < 48) { f32x4 s; s.x = sigmoidf_(v.x); s.y = sigmoidf_(v.y); s.z = sigmoidf_(v.z); s.w = sigmoidf_(v.w); *(f32x4*)(GATE + (size_t)row * 48 + cl) = s; }
                               else if (cl < 64) *(f32x4*)(DTR + (size_t)row * 16 + (cl - 48)) = v; }
                    }
            }
    }
};
struct EpiF32 {
    static constexpr bool PERM = false, AFTER_DRAIN = false;
    float* O; int ldc;
    __device__ __forceinline__ void operator()(const pg8::f32x4 (&acc)[2][2][4][2], const pg8::Unit& u, int wr, int wc, int fr, int fq) const {
#pragma unroll
        for (int ai = 0; ai < 2; ++ai)
#pragma unroll
            for (int m = 0; m < 4; ++m) { float* rowp = O + (size_t)(u.pm * 256 + ai * 128 + wr * 64 + m * 16 + fr) * ldc + u.pn * 256 + wc * 32 + fq * 4;
#pragma unroll
                for (int bj = 0; bj < 2; ++bj)
#pragma unroll
                    for (int n = 0; n < 2; ++n) *(f32x4*)(rowp + bj * 128 + n * 16) = acc[ai][bj][m][n]; }
    }
};
struct EpiGate {
    static constexpr bool PERM = false, AFTER_DRAIN = false;
    bf16* GP; float* out;
    __device__ __forceinline__ void operator()(const pg8::f32x4 (&acc)[2][2][4][2], const pg8::Unit& u, int wr, int wc, int fr, int fq) const {
#pragma unroll
        for (int ai = 0; ai < 2; ++ai)
#pragma unroll
            for (int m = 0; m < 4; ++m) { const int row = u.pm * 256 + ai * 128 + wr * 64 + m * 16 + fr;
                const bool isp = row < MP; const int b = isp ? (row >> 11) : ((row - MP) >> 3); const int t = isp ? (row & 2047) : ((row - MP) & 7);
                const int tl = isp ? t - (TP - 2) : t - (TS - 2);
#pragma unroll
                for (int bj = 0; bj < 2; ++bj)
#pragma unroll
                    for (int n = 0; n < 2; ++n) { const int col = u.pn * 256 + bj * 128 + wc * 32 + n * 16 + fq * 4; const f32x4 v = acc[ai][bj][m][n];
                        u32x2 w; w.x = pk2(v.x, v.y); w.y = pk2(v.z, v.w); *(u32x2*)(GP + (size_t)row * DFFP + col) = w;
                        if (tl >= 0 && col < DFF) { float* dst = isp ? out + O_FCP + ((size_t)b * 2 + tl) * DFF + col : out + O_FCS + ((size_t)b * 2 + tl) * DFF + col; *(f32x4*)dst = v; } } }
    }
};
struct EpiUp {
    static constexpr bool PERM = false, AFTER_DRAIN = false;
    const bf16* GP; bf16* ACT; const float* dww; const float* dwb; const float* hist;
    __device__ __forceinline__ void operator()(const pg8::f32x4 (&acc)[2][2][4][2], const pg8::Unit& u, int wr, int wc, int fr, int fq) const {
#pragma unroll
        for (int bj = 0; bj < 2; ++bj)
#pragma unroll
            for (int n = 0; n < 2; ++n) { const int col = u.pn * 256 + bj * 128 + wc * 32 + n * 16 + fq * 4;
                const bool live = col < DFF; const int cc = live ? col : 0;
                const f32x4 w0 = *(const f32x4*)(dww + cc), w1 = *(const f32x4*)(dww + DFF + cc), w2 = *(const f32x4*)(dww + 2 * DFF + cc), bb = *(const f32x4*)(dwb + cc);
#pragma unroll
                for (int ai = 0; ai < 2; ++ai)
#pragma unroll
                    for (int m = 0; m < 4; ++m) { const int row = u.pm * 256 + ai * 128 + wr * 64 + m * 16 + fr;
                        const bool isp = row < MP; const int b = isp ? (row >> 11) : ((row - MP) >> 3); const int t = isp ? (row & 2047) : ((row - MP) & 7);
                        f32x4 g[3];
#pragma unroll
                        for (int k = 0; k < 3; ++k) { const int tt = t - 2 + k;
                            if (tt >= 0) { const u32x2 p = *(const u32x2*)(GP + (size_t)(row - 2 + k) * DFFP + col); g[k] = (f32x4){__uint_as_float(p.x << 16), __uint_as_float(p.x & 0xffff0000u), __uint_as_float(p.y << 16), __uint_as_float(p.y & 0xffff0000u)}; }
                            else if (isp || !live) g[k] = (f32x4){0.f, 0.f, 0.f, 0.f};
                            else g[k] = *(const f32x4*)(hist + ((size_t)b * 2 + (2 + tt)) * DFF + cc); }
                        const f32x4 cv = bb + w0 * g[0] + w1 * g[1] + w2 * g[2]; const f32x4 up = acc[ai][bj][m][n];
                        f32x4 a; a.x = gelu_tanh(cv.x) * up.x; a.y = gelu_tanh(cv.y) * up.y; a.z = gelu_tanh(cv.z) * up.z; a.w = gelu_tanh(cv.w) * up.w;
                        if (!live) a = (f32x4){0.f, 0.f, 0.f, 0.f};
                        u32x2 w; w.x = pk2(a.x, a.y); w.y = pk2(a.z, a.w); *(u32x2*)(ACT + (size_t)row * DFFP + col) = w; } }
    }
};

DI void compress_unit(Frame& F, int unit) {
    const int lane = F.lane, r = lane & 31, h = lane >> 5, w = F.wave, kv = w >> 2, q = w & 3;
    const bool isp = unit < 16; const int b = isp ? (unit >> 2) : ((unit - 16) >> 2), g = unit & 3;
    const bf16* W12T = wsp<bf16>(F, WS_W12) + (size_t)kv * 256 * 1024;
    const float* kvp = F.out + O_KVP; const float* cache = F.in[I_CKV]; const int* ptb = F.pt + b * 16;
    f32x16 a0[4], a1[4];
#pragma unroll
    for (int m = 0; m < 4; ++m) { a0[m] = (f32x16){}; a1[m] = (f32x16){}; }
    const bf16* b0p = W12T + (size_t)(32 * q + r) * 1024 + 8 * h; const bf16* b1p = W12T + (size_t)(128 + 32 * q + r) * 1024 + 8 * h;
    const int coff = kv * 256 + g * 64 + 8 * h;
    for (int s = 0; s < 16; ++s) {
        const float* rp[4];
#pragma unroll
        for (int m = 0; m < 4; ++m) { const int tt = 16 * (32 * m + r) + s;
            rp[m] = (isp ? kvp + ((size_t)(b * 2048 + tt)) * 1024 : cache + ((size_t)ptb[tt >> 7] * 128 + (tt & 127)) * 1024) + coff; }
#pragma unroll
        for (int dd = 0; dd < 4; ++dd) {
            const bf16x8 bf0 = *(const bf16x8*)(b0p + s * 64 + dd * 16), bf1 = *(const bf16x8*)(b1p + s * 64 + dd * 16);
#pragma unroll
            for (int m = 0; m < 4; ++m) { const f32x4 x0 = *(const f32x4*)(rp[m] + dd * 16), x1 = *(const f32x4*)(rp[m] + dd * 16 + 4); const bf16x8 af = cvt8(x0, x1);
                a0[m] = MFMA32(af, bf0, a0[m]); a1[m] = MFMA32(af, bf1, a1[m]); }
        }
    }
    LAS bf16* G = (LAS bf16*)F.lds + (size_t)kv * 128 * 136;
    float cb = F.in[I_CB1][kv * 128 + 32 * q + r];
    { const float* CBP = wsp<float>(F, WS_CBP) + kv * 8 * 128 + 32 * q + r;
#pragma unroll
      for (int p = 0; p < 8; ++p) cb += CBP[p * 128]; }
    float PT[4][4];
#pragma unroll
    for (int m = 0; m < 4; ++m)
#pragma unroll
        for (int a = 0; a < 4; ++a) PT[m][a] = __shfl_xor(a1[m][4 * a], 32);
#pragma unroll
    for (int m = 0; m < 4; ++m)
#pragma unroll
        for (int a = 0; a < 4; ++a)
#pragma unroll
            for (int c = 0; c < 4; ++c) {
                float nx;
                if (c < 3) nx = a1[m][4 * a + c + 1];
                else { const float n1 = (a < 3) ? PT[m][(a + 1) & 3] : ((m < 3) ? PT[(m + 1) & 3][0] : 0.f); nx = h ? n1 : PT[m][a]; }
                const float hid = a0[m][4 * a + c] + nx + cb; const int n = 32 * m + 8 * a + 4 * h + c;
                G[n * 136 + 32 * q + r] = (bf16)(pk2(gelu_tanh(hid), 0.f) & 0xffffu);
            }
    __syncthreads();
    { const int m2 = q; const bf16* W2T = wsp<bf16>(F, WS_W2T) + (size_t)kv * 64 * 128;
      f32x16 o0 = (f32x16){}, o1 = (f32x16){};
#pragma unroll
      for (int ks = 0; ks < 8; ++ks) { const bf16x8 af = *(const LAS bf16x8*)(G + (32 * m2 + r) * 136 + 16 * ks + 8 * h);
          const bf16x8 w0 = *(const bf16x8*)(W2T + (size_t)r * 128 + 16 * ks + 8 * h), w1 = *(const bf16x8*)(W2T + (size_t)(32 + r) * 128 + 16 * ks + 8 * h);
          o0 = MFMA32(af, w0, o0); o1 = MFMA32(af, w1, o1); }
      const float bb0 = F.in[I_CB2][kv * 64 + r], bb1 = F.in[I_CB2][kv * 64 + 32 + r];
      if (kv == 0) { bf16* KCK = wsp<bf16>(F, WS_KCK) + (size_t)unit * 8192;
#pragma unroll
          for (int reg = 0; reg < 16; ++reg) { const int n = 32 * m2 + crow(reg, h); KCK[n * 64 + r] = (bf16)(pk2(o0[reg] + bb0, 0.f) & 0xffffu); KCK[n * 64 + 32 + r] = (bf16)(pk2(o1[reg] + bb1, 0.f) & 0xffffu); } }
      else { bf16* KCVT = wsp<bf16>(F, WS_KCVT) + (size_t)unit * 8192;
#pragma unroll
          for (int a = 0; a < 4; ++a) { const int n = 32 * m2 + 8 * a + 4 * h;
              u32x2 x0; x0.x = pk2(o0[4 * a] + bb0, o0[4 * a + 1] + bb0); x0.y = pk2(o0[4 * a + 2] + bb0, o0[4 * a + 3] + bb0); *(u32x2*)(KCVT + (size_t)r * 128 + n) = x0;
              u32x2 x1; x1.x = pk2(o1[4 * a] + bb1, o1[4 * a + 1] + bb1); x1.y = pk2(o1[4 * a + 2] + bb1, o1[4 * a + 3] + bb1); *(u32x2*)(KCVT + (size_t)(32 + r) * 128 + n) = x1; } }
    }
    __syncthreads();
}

DI void ssm_pre(Frame& F) {
    const float* XBC = wsp<float>(F, WS_XBC); float* XBCC = wsp<float>(F, WS_XBCC); const float* DTR = wsp<float>(F, WS_DTR); float* DT = wsp<float>(F, WS_DT);
    const float* cw = F.in[I_SCW]; const float* cbias = F.in[I_SCB]; const float* hist = F.in[I_SCONV];
    const int gt = F.vcu * NTHR + F.tid, NGT = F.G * NTHR;
    for (int i = gt; i < MT * 512; i += NGT) { const int row = i >> 9, c = (i & 511) * 4;
        const bool isp = row < MP; const int b = isp ? (row >> 11) : ((row - MP) >> 3); const int t = isp ? (row & 2047) : ((row - MP) & 7);
        f32x4 acc = *(const f32x4*)(cbias + c);
#pragma unroll
        for (int k = 0; k < 4; ++k) { const int tt = t - 3 + k; f32x4 xv;
            if (tt >= 0) xv = *(const f32x4*)(XBC + (size_t)(row - 3 + k) * 2048 + c);
            else if (isp) xv = (f32x4){0.f, 0.f, 0.f, 0.f};
            else xv = *(const f32x4*)(hist + ((size_t)b * 3 + (3 + tt)) * 2048 + c);
            acc += *(const f32x4*)(cw + k * 2048 + c) * xv; }
        f32x4 o; o.x = siluf_(acc.x); o.y = siluf_(acc.y); o.z = siluf_(acc.z); o.w = siluf_(acc.w);
        *(f32x4*)(XBCC + (size_t)row * 2048 + c) = o;
        if (isp) { if (t >= TP - 3) *(f32x4*)(F.out + O_SCP + ((size_t)b * 3 + (t - (TP - 3))) * 2048 + c) = *(const f32x4*)(XBC + (size_t)row * 2048 + c); }
        else { if (t >= TS - 3) *(f32x4*)(F.out + O_SCS + ((size_t)b * 3 + (t - (TS - 3))) * 2048 + c) = *(const f32x4*)(XBC + (size_t)row * 2048 + c); }
    }
    for (int i = gt; i < MT * 16; i += NGT) DT[i] = softplusf_(DTR[i] + F.in[I_DTB][i & 15]);
}

struct AState { float m, l; f32x16 o0, o1; };
DI void astate_init(AState& s) { s.m = NEGF; s.l = 0.f; s.o0 = (f32x16){}; s.o1 = (f32x16){}; }
DI bf16x8 pack8(const f32x16& x, int s) {
    u32x4 p; p.x = pk2(x[8 * s], x[8 * s + 1]); p.y = pk2(x[8 * s + 2], x[8 * s + 3]); p.z = pk2(x[8 * s + 4], x[8 * s + 5]); p.w = pk2(x[8 * s + 6], x[8 * s + 7]); return __builtin_bit_cast(bf16x8, p);
}
struct MaskBias {
    int t;
    unsigned long long mask;
    bool use_mask;
    int kbase;
    int maxdist;
    int klimit;
    int hd;
    const LAS float* lut;
    DI float score(float raw, int tile, int kk) const {
        const int kidx = tile * 64 + kk, dist = t - (kbase + kidx);
        bool valid = dist >= 0 && dist <= maxdist && kidx < klimit;
        if (use_mask) valid = valid && ((mask >> tile) & 1ull);
        const int dc = dist < 0 ? 0 : (dist > 127 ? 127 : dist);
        return valid ? raw * 0.125f + lut[dc * 16 + hd] : NEGF;
    }
};
struct KVbf {
    const bf16* K; const bf16* VT; int vpitch;
    DI bf16x8 kfrag(int tile, int kh, int step, int r, int h) const { return *(const bf16x8*)(K + (size_t)(tile * 64 + kh * 32 + r) * 64 + step * 16 + h * 8); }
    DI bf16x8 vfrag(int tile, int kh, int s, int dg, int r, int h) const { const bf16* p = VT + (size_t)(dg * 32 + r) * vpitch + tile * 64 + kh * 32 + s * 16 + h * 4;
        const s16x4 lo = *(const s16x4*)p, hi = *(const s16x4*)(p + 8); return __builtin_shufflevector(lo, hi, 0, 1, 2, 3, 4, 5, 6, 7); }
};
struct KVselS {
    const float* cache; const int* ptb; const float* kvs; int g;
    DI const float* row(int kidx) const { return kidx < 2048 ? cache + ((size_t)ptb[kidx >> 7] * 128 + (kidx & 127)) * 1024 : kvs + (size_t)((kidx - 2048) < 8 ? (kidx - 2048) : 7) * 1024; }
    DI bf16x8 kfrag(int tile, int kh, int step, int r, int h) const { const float* p = row(tile * 64 + kh * 32 + r) + 2 * 256 + g * 64 + step * 16 + h * 8; return cvt8(*(const f32x4*)p, *(const f32x4*)(p + 4)); }
    DI bf16x8 vfrag(int tile, int kh, int s, int dg, int r, int h) const { float v[8];
#pragma unroll
        for (int j = 0; j < 8; ++j) v[j] = row(tile * 64 + kh * 32 + 16 * s + 8 * (j >> 2) + 4 * h + (j & 3))[3 * 256 + g * 64 + dg * 32 + r];
        u32x4 p; p.x = pk2(v[0], v[1]); p.y = pk2(v[2], v[3]); p.z = pk2(v[4], v[5]); p.w = pk2(v[6], v[7]); return __builtin_bit_cast(bf16x8, p); }
};
struct KVwinS {
    const float* cw; const float* wo; int g;
    DI const float* row(int idx) const { const int i2 = idx > 519 ? 519 : idx; return i2 < 512 ? cw + (size_t)i2 * 512 : wo + (size_t)(i2 - 8) * 512; }
    DI bf16x8 kfrag(int tile, int kh, int step, int r, int h) const { const float* p = row(tile * 64 + kh * 32 + r) + g * 64 + step * 16 + h * 8; return cvt8(*(const f32x4*)p, *(const f32x4*)(p + 4)); }
    DI bf16x8 vfrag(int tile, int kh, int s, int dg, int r, int h) const { float v[8];
#pragma unroll
        for (int j = 0; j < 8; ++j) v[j] = row(tile * 64 + kh * 32 + 16 * s + 8 * (j >> 2) + 4 * h + (j & 3))[256 + g * 64 + dg * 32 + r];
        u32x4 p; p.x = pk2(v[0], v[1]); p.y = pk2(v[2], v[3]); p.z = pk2(v[4], v[5]); p.w = pk2(v[6], v[7]); return __builtin_bit_cast(bf16x8, p); }
};
template <class KV> DI void attn_tile(AState& st, const bf16x8 (&qf)[4], const KV& kv, int tile, const MaskBias& mb, int r, int h) {
    f32x16 s0 = (f32x16){}, s1 = (f32x16){};
#pragma unroll
    for (int step = 0; step < 4; ++step) { const bf16x8 k0 = kv.kfrag(tile, 0, step, r, h), k1 = kv.kfrag(tile, 1, step, r, h); s0 = MFMA32(k0, qf[step], s0); s1 = MFMA32(k1, qf[step], s1); }
    float tmax = NEGF;
#pragma unroll
    for (int reg = 0; reg < 16; ++reg) { const int kk = crow(reg, h); s0[reg] = mb.score(s0[reg], tile, kk); s1[reg] = mb.score(s1[reg], tile, 32 + kk); tmax = fmaxf(tmax, fmaxf(s0[reg], s1[reg])); }
    tmax = fmaxf(tmax, __shfl_xor(tmax, 32));
    const float mnew = fmaxf(st.m, tmax), alpha = __expf(st.m - mnew);
    float ls = 0.f;
#pragma unroll
    for (int reg = 0; reg < 16; ++reg) { const float p0 = s0[reg] > -1e29f ? __expf(s0[reg] - mnew) : 0.f, p1 = s1[reg] > -1e29f ? __expf(s1[reg] - mnew) : 0.f; s0[reg] = p0; s1[reg] = p1; ls += p0 + p1; }
    ls += __shfl_xor(ls, 32);
    st.l = st.l * alpha + ls; st.m = mnew;
    if (__any(alpha != 1.0f)) {
#pragma unroll
        for (int reg = 0; reg < 16; ++reg) { const float a = __shfl(alpha, crow(reg, h)); st.o0[reg] *= a; st.o1[reg] *= a; }
    }
#pragma unroll
    for (int s = 0; s < 2; ++s) { const bf16x8 pf = pack8(s0, s); st.o0 = MFMA32(pf, kv.vfrag(tile, 0, s, 0, r, h), st.o0); st.o1 = MFMA32(pf, kv.vfrag(tile, 0, s, 1, r, h), st.o1); }
#pragma unroll
    for (int s = 0; s < 2; ++s) { const bf16x8 pf = pack8(s1, s); st.o0 = MFMA32(pf, kv.vfrag(tile, 1, s, 0, r, h), st.o0); st.o1 = MFMA32(pf, kv.vfrag(tile, 1, s, 1, r, h), st.o1); }
}
DI unsigned long long cmp_branch(const bf16x8 (&qf)[4], const bf16* KCK, const bf16* KCVT, int tq, int hd, const LAS float* lut, int ns, volatile LAS float* scr, f32x16& oc0, f32x16& oc1, int lane) {
    const int r = lane & 31, h = lane >> 5, qi = r >> 2;
    KVbf kv{KCK, KCVT, 128};
    f32x16 S[4];
#pragma unroll
    for (int T = 0; T < 4; ++T) { S[T] = (f32x16){};
#pragma unroll
        for (int step = 0; step < 4; ++step) S[T] = MFMA32(kv.kfrag(T >> 1, T & 1, step, r, h), qf[step], S[T]); }
    asm volatile("" ::: "memory");
    float mx = NEGF;
#pragma unroll
    for (int T = 0; T < 4; ++T)
#pragma unroll
        for (int reg = 0; reg < 16; ++reg) { const int n = 32 * T + crow(reg, h), dist = tq - (16 * n + 31); const int dc = dist < 0 ? 0 : (dist > 127 ? 127 : dist);
            const float s = dist >= 0 ? S[T][reg] * 0.125f + lut[dc * 16 + hd] : NEGF; S[T][reg] = s; mx = fmaxf(mx, s); }
    mx = fmaxf(mx, __shfl_xor(mx, 32));
    float l = 0.f;
#pragma unroll
    for (int T = 0; T < 4; ++T)
#pragma unroll
        for (int reg = 0; reg < 16; ++reg) { const float p = S[T][reg] > -1e29f ? __expf(S[T][reg] - mx) : 0.f; S[T][reg] = p; l += p; }
    l += __shfl_xor(l, 32);
    const float inv = 1.0f / fmaxf(l, TINYF);
#pragma unroll
    for (int T = 0; T < 4; ++T) S[T] *= inv;
    volatile LAS float* impA = scr; volatile LAS float* impB = scr + 8 * 34;
#pragma unroll
    for (int T = 0; T < 4; ++T)
#pragma unroll
        for (int a = 0; a < 4; ++a) { float e = S[T][4 * a] + S[T][4 * a + 1] + S[T][4 * a + 2] + 0.5f * S[T][4 * a + 3], c = 0.5f * S[T][4 * a + 3];
            e += __shfl_xor(e, 1); e += __shfl_xor(e, 2); c += __shfl_xor(c, 1); c += __shfl_xor(c, 2);
            if ((r & 3) == 0) { const int s = 8 * T + 2 * a + h; impA[qi * 34 + s] = e; impB[qi * 34 + s + 1] = c; } }
    if (lane < 8) { impB[lane * 34] = 0.f; impA[lane * 34 + 32] = 0.f; }
    LDS_WAIT();
    const int tq_l = __shfl(tq, (lane & 7) * 4);
    if (lane < 8) { const int qb = tq_l >> 6; unsigned long long sel = 0ull;
        for (int it = 0; it < 8; ++it) { int best = -1; float bv = -3.0e38f;
            for (int s = 0; s <= qb && s < ns; ++s) { if ((sel >> s) & 1ull) continue; float v = impA[lane * 34 + s] + impB[lane * 34 + s]; if (s == 0 || s == qb || s == qb - 1) v += 1.0e4f; if (v > bv) { bv = v; best = s; } }
            if (best >= 0) sel |= (1ull << best); }
        scr[8 * 34 * 2 + 2 * lane] = __uint_as_float((unsigned)sel); scr[8 * 34 * 2 + 2 * lane + 1] = __uint_as_float((unsigned)(sel >> 32)); }
    LDS_WAIT();
    const unsigned long long mask = (unsigned long long)__float_as_uint(scr[8 * 34 * 2 + 2 * qi]) | ((unsigned long long)__float_as_uint(scr[8 * 34 * 2 + 2 * qi + 1]) << 32);
    oc0 = (f32x16){}; oc1 = (f32x16){};
#pragma unroll
    for (int T = 0; T < 4; ++T)
#pragma unroll
        for (int s = 0; s < 2; ++s) { asm volatile("" ::: "memory"); const bf16x8 pf = pack8(S[T], s); oc0 = MFMA32(pf, kv.vfrag(T >> 1, T & 1, s, 0, r, h), oc0); oc1 = MFMA32(pf, kv.vfrag(T >> 1, T & 1, s, 1, r, h), oc1); }
    return mask;
}
DI void attn_prompt_unit(Frame& F, int wu, volatile LAS float* scr, volatile LAS float* ost) {
    const int lane = F.lane, r = lane & 31, h = lane >> 5, qi = r >> 2, rh = r & 3;
    const int bg = wu >> 8, qo = wu & 255, b = bg >> 2, g = bg & 3, t = 8 * qo + qi, row = b * 2048 + t, hd = g * 4 + rh;
    const LAS float* lut = (const LAS float*)(F.lds + LUT_OFF);
    const bf16* QB = wsp<bf16>(F, WS_QB);
    bf16x8 qf[4];
#pragma unroll
    for (int step = 0; step < 4; ++step) qf[step] = *(const bf16x8*)(QB + (size_t)row * 1024 + hd * 64 + step * 16 + h * 8);
    f32x16 oc0, oc1;
    const unsigned long long mask = cmp_branch(qf, wsp<bf16>(F, WS_KCK) + (size_t)bg * 8192, wsp<bf16>(F, WS_KCVT) + (size_t)bg * 8192, t, hd, lut, 32, scr, oc0, oc1, lane);
    unsigned long long om = mask;
#pragma unroll
    for (int o = 4; o < 32; o <<= 1) om |= __shfl_xor(om, o);
    om = __shfl(om, 0);
    const int qb = qo >> 3;
    const float* GATE = wsp<float>(F, WS_GATE) + (size_t)row * 48;
    { const float f0 = GATE[hd];
#pragma unroll
      for (int reg = 0; reg < 16; ++reg) { const float a0 = __shfl(f0, crow(reg, h)); ost[(reg * 2) * 64 + lane] = a0 * oc0[reg]; ost[(reg * 2 + 1) * 64 + lane] = a0 * oc1[reg]; } }
    { AState ss; astate_init(ss);
      KVbf kv{wsp<bf16>(F, WS_KB) + (size_t)((b * 2 + 0) * 4 + g) * 2048 * 64, wsp<bf16>(F, WS_VT) + (size_t)((b * 2 + 0) * 4 + g) * 64 * 2048, 2048};
      MaskBias mb{t, mask, true, 0, 1 << 30, 1 << 30, hd, lut};
#pragma unroll 1
      for (int j = 0; j <= qb; ++j) { if (!((om >> j) & 1ull)) continue; attn_tile(ss, qf, kv, j, mb, r, h); }
      const float f1 = GATE[16 + hd] / fmaxf(ss.l, TINYF);
#pragma unroll
      for (int reg = 0; reg < 16; ++reg) { const float a1 = __shfl(f1, crow(reg, h)); ost[(reg * 2) * 64 + lane] += a1 * ss.o0[reg]; ost[(reg * 2 + 1) * 64 + lane] += a1 * ss.o1[reg]; } }
    { AState sw; astate_init(sw);
      KVbf kv{wsp<bf16>(F, WS_KB) + (size_t)((b * 2 + 1) * 4 + g) * 2048 * 64, wsp<bf16>(F, WS_VT) + (size_t)((b * 2 + 1) * 4 + g) * 64 * 2048, 2048};
      MaskBias mb{t, 0ull, false, 0, 512, 1 << 30, hd, lut};
      const int j0 = (8 * qo - 512) < 0 ? 0 : ((8 * qo - 512) >> 6);
#pragma unroll 1
      for (int j = j0; j <= qb; ++j) attn_tile(sw, qf, kv, j, mb, r, h);
      const float f2 = GATE[32 + hd] / fmaxf(sw.l, TINYF);
      bf16* MIX = wsp<bf16>(F, WS_MIX);
#pragma unroll
      for (int reg = 0; reg < 16; ++reg) { const int qr = crow(reg, h); const float a2 = __shfl(f2, qr);
          const float v0 = ost[(reg * 2) * 64 + lane] + a2 * sw.o0[reg], v1 = ost[(reg * 2 + 1) * 64 + lane] + a2 * sw.o1[reg];
          bf16* op = MIX + (size_t)(b * 2048 + 8 * qo + (qr >> 2)) * 2048 + (g * 4 + (qr & 3)) * 64;
          op[r] = (bf16)(pk2(v0, 0.f) & 0xffffu); op[32 + r] = (bf16)(pk2(v1, 0.f) & 0xffffu); } }
}
DI void attn_sample_unit(Frame& F, int su) {
    const int lane = F.lane, r = lane & 31, h = lane >> 5, qi = r >> 2, rh = r & 3, w = F.wave;
    const int b = su >> 2, g = su & 3, t = 2048 + qi, row = MP + b * 8 + qi, hd = g * 4 + rh;
    const LAS float* lut = (const LAS float*)(F.lds + LUT_OFF);
    volatile LAS float* scr = (volatile LAS float*)(F.lds + w * 4096);
    LAS float* MB_ = (LAS float*)(F.lds + 32768);
    LAS float* OB = (LAS float*)(F.lds + 32768 + 2048);
    LAS float* OUT = (LAS float*)(F.lds + 32768 + 2048 + 65536);
    const bf16* QB = wsp<bf16>(F, WS_QB);
    bf16x8 qf[4];
#pragma unroll
    for (int step = 0; step < 4; ++step) qf[step] = *(const bf16x8*)(QB + (size_t)row * 1024 + hd * 64 + step * 16 + h * 8);
    f32x16 oc0, oc1;
    const int unit = 16 + su;
    const unsigned long long mask = cmp_branch(qf, wsp<bf16>(F, WS_KCK) + (size_t)unit * 8192, wsp<bf16>(F, WS_KCVT) + (size_t)unit * 8192, t, hd, lut, 33, scr, oc0, oc1, lane);
    unsigned long long om = mask;
#pragma unroll
    for (int o = 4; o < 32; o <<= 1) om |= __shfl_xor(om, o);
    om = __shfl(om, 0);
    const float* GATE = wsp<float>(F, WS_GATE) + (size_t)row * 48;
    if (w == 0) { const float f0 = GATE[hd];
#pragma unroll
        for (int reg = 0; reg < 16; ++reg) { const int qr = crow(reg, h); const float a0 = __shfl(f0, qr); OUT[qr * 64 + r] = a0 * oc0[reg]; OUT[qr * 64 + 32 + r] = a0 * oc1[reg]; } }
#pragma unroll 1
    for (int br = 0; br < 2; ++br) {
        AState st; astate_init(st);
        if (br == 0) { KVselS kv{F.in[I_CKV], F.pt + b * 16, F.out + O_KVS + (size_t)b * 8 * 1024, g}; MaskBias mb{t, mask, true, 0, 1 << 30, 2056, hd, lut};
            for (int j = w; j < 33; j += 8) { if (!((om >> j) & 1ull)) continue; attn_tile(st, qf, kv, j, mb, r, h); } }
        else { KVwinS kv{F.in[I_CWIN] + (size_t)b * 512 * 512, F.out + O_WINS + (size_t)b * 512 * 512, g}; MaskBias mb{t, 0ull, false, 1536, 512, 520, hd, lut};
            for (int j = (w == 7 ? 7 : w); j < 9; j += (w == 7 ? 1 : 16)) attn_tile(st, qf, kv, j, mb, r, h); }
        __syncthreads();
        if (h == 0) { MB_[w * 32 + r] = st.m; MB_[256 + w * 32 + r] = st.l; }
#pragma unroll
        for (int reg = 0; reg < 16; ++reg) { const int qr = crow(reg, h); OB[(w * 32 + qr) * 64 + r] = st.o0[reg]; OB[(w * 32 + qr) * 64 + 32 + r] = st.o1[reg]; }
        __syncthreads();
        { const int qr = F.tid >> 4, d4 = (F.tid & 15) * 4; float M = NEGF;
#pragma unroll
          for (int ww = 0; ww < 8; ++ww) M = fmaxf(M, MB_[ww * 32 + qr]);
          float L = 0.f; f32x4 O = {0.f, 0.f, 0.f, 0.f};
#pragma unroll
          for (int ww = 0; ww < 8; ++ww) { const float e = __expf(MB_[ww * 32 + qr] - M); L += MB_[256 + ww * 32 + qr] * e; O += *(const LAS f32x4*)(OB + (ww * 32 + qr) * 64 + d4) * e; }
          const float gt = wsp<float>(F, WS_GATE)[(size_t)(MP + b * 8 + (qr >> 2)) * 48 + (br + 1) * 16 + g * 4 + (qr & 3)] / fmaxf(L, TINYF);
          *(LAS f32x4*)(OUT + qr * 64 + d4) += O * gt; }
    }
    __syncthreads();
    { const int qr = F.tid >> 4, d4 = (F.tid & 15) * 4; const f32x4 v = *(const LAS f32x4*)(OUT + qr * 64 + d4);
      u32x2 o; o.x = pk2(v.x, v.y); o.y = pk2(v.z, v.w); *(u32x2*)(wsp<bf16>(F, WS_MIX) + (size_t)(MP + b * 8 + (qr >> 2)) * 2048 + (g * 4 + (qr & 3)) * 64 + d4) = o; }
    __syncthreads();
}

DI void ssm_item(Frame& F, int it) {
    const bool isp = it < 256; const int its = isp ? it : it - 256;
    const int b = its >> 6, head = (its >> 2) & 15, pq = its & 3, g = head >> 2;
    const int T = isp ? TP : TS, row0 = isp ? b * TP : MP + b * TS;
    const int p = 16 * pq + (F.tid >> 5), nc = F.tid & 31;
    const float* XBCC = wsp<float>(F, WS_XBCC); const float* DT = wsp<float>(F, WS_DT); float* YS = wsp<float>(F, WS_YSSM);
    const float A = -__expf(F.in[I_ALOG][head]);
    const size_t soff = ((size_t)(b * 16 + head) * 64 + p) * 128 + 4 * nc;
    f32x4 hs = isp ? (f32x4){0.f, 0.f, 0.f, 0.f} : *(const f32x4*)(F.in[I_SSM] + soff);
    const float* xr = XBCC + (size_t)row0 * 2048;
#pragma unroll 8
    for (int t = 0; t < T; ++t) {
        const float* rp = xr + (size_t)t * 2048;
        const float dtv = DT[(size_t)(row0 + t) * 16 + head];
        const float x = rp[head * 64 + p] * dtv, dA = __expf(dtv * A);
        const f32x4 Bv = *(const f32x4*)(rp + 1024 + g * 128 + 4 * nc), Cv = *(const f32x4*)(rp + 1536 + g * 128 + 4 * nc);
        hs = hs * dA + Bv * x;
        float y = (Cv.x * hs.x + Cv.y * hs.y) + (Cv.z * hs.z + Cv.w * hs.w);
        y += __shfl_xor(y, 16); y += __shfl_xor(y, 8); y += __shfl_xor(y, 4); y += __shfl_xor(y, 2); y += __shfl_xor(y, 1);
        if (nc == 0) YS[(size_t)(row0 + t) * 1024 + head * 64 + p] = y;
    }
    *(f32x4*)(F.out + (isp ? O_SSP : O_SSS) + soff) = hs;
}
DI void ssm_post(Frame& F) {
    const float* YS = wsp<float>(F, WS_YSSM); const float* XBCC = wsp<float>(F, WS_XBCC); const float* ZF = wsp<float>(F, WS_ZF); bf16* MIX = wsp<bf16>(F, WS_MIX);
    const int gw = F.vcu * NWAVES + F.wave, NGW = F.G * NWAVES, lane = F.lane;
    for (int i = gw; i < MT * 4; i += NGW) { const int row = i >> 2, g = i & 3, c = g * 256 + lane * 4;
        const f32x4 y = *(const f32x4*)(YS + (size_t)row * 1024 + c), x = *(const f32x4*)(XBCC + (size_t)row * 2048 + c), z = *(const f32x4*)(ZF + (size_t)row * 1024 + c);
        const float D = F.in[I_SD][c >> 6];
        f32x4 v = y + x * D; v.x *= siluf_(z.x); v.y *= siluf_(z.y); v.z *= siluf_(z.z); v.w *= siluf_(z.w);
        const float ss = wave_sum((v.x * v.x + v.y * v.y) + (v.z * v.z + v.w * v.w));
        const float rs = 1.0f / sqrtf(ss * (1.f / 256.f) + EPS);
        const f32x4 gg = *(const f32x4*)(F.in[I_SNG] + c);
        u32x2 o; o.x = pk2(v.x * rs * gg.x, v.y * rs * gg.y); o.y = pk2(v.z * rs * gg.z, v.w * rs * gg.w);
        *(u32x2*)(MIX + (size_t)row * 2048 + 1024 + c) = o; }
}
DI void norm1(Frame& F) {
    const float* MIXO = wsp<float>(F, WS_MIXO); float* X1 = wsp<float>(F, WS_X1); bf16* H = wsp<bf16>(F, WS_XN);
    const int gw = F.vcu * NWAVES + F.wave, NGW = F.G * NWAVES, lane = F.lane;
    for (int m = gw; m < MT; m += NGW) {
        const f32x4* mr = (const f32x4*)(MIXO + (size_t)m * DM) + lane; const f32x4* xr = (const f32x4*)(m < MP ? F.in[I_XP] + (size_t)m * DM : F.in[I_XS] + (size_t)(m - MP) * DM) + lane;
        const f32x4* g1 = (const f32x4*)F.in[I_LNPOST] + lane; const f32x4* g2 = (const f32x4*)F.in[I_LNFPRE] + lane;
        f32x4 v[8]; float s = 0.f;
#pragma unroll
        for (int j = 0; j < 8; ++j) { v[j] = mr[64 * j]; s += (v[j].x * v[j].x + v[j].y * v[j].y) + (v[j].z * v[j].z + v[j].w * v[j].w); }
        const float rs = 1.0f / sqrtf(wave_sum(s) * (1.f / DM) + EPS); float s2 = 0.f;
#pragma unroll
        for (int j = 0; j < 8; ++j) { v[j] = xr[64 * j] + v[j] * rs * g1[64 * j]; s2 += (v[j].x * v[j].x + v[j].y * v[j].y) + (v[j].z * v[j].z + v[j].w * v[j].w); ((f32x4*)(X1 + (size_t)m * DM) + lane)[64 * j] = v[j]; }
        const float rs2 = 1.0f / sqrtf(wave_sum(s2) * (1.f / DM) + EPS);
        u32x2* o8 = (u32x2*)(H + (size_t)m * DM) + lane;
#pragma unroll
        for (int j = 0; j < 8; ++j) { const f32x4 gg = g2[64 * j]; u32x2 w; w.x = pk2(v[j].x * rs2 * gg.x, v[j].y * rs2 * gg.y); w.y = pk2(v[j].z * rs2 * gg.z, v[j].w * rs2 * gg.w); o8[64 * j] = w; }
    }
}
DI void norm2(Frame& F) {
    const float* FFN = wsp<float>(F, WS_FFN); const float* X1 = wsp<float>(F, WS_X1);
    const int gw = F.vcu * NWAVES + F.wave, NGW = F.G * NWAVES, lane = F.lane;
    for (int m = gw; m < MT; m += NGW) {
        const f32x4* fr_ = (const f32x4*)(FFN + (size_t)m * DM) + lane; const f32x4* xr = (const f32x4*)(X1 + (size_t)m * DM) + lane; const f32x4* g3 = (const f32x4*)F.in[I_LNFPOST] + lane;
        f32x4 v[8]; float s = 0.f;
#pragma unroll
        for (int j = 0; j < 8; ++j) { v[j] = fr_[64 * j]; s += (v[j].x * v[j].x + v[j].y * v[j].y) + (v[j].z * v[j].z + v[j].w * v[j].w); }
        const float rs = 1.0f / sqrtf(wave_sum(s) * (1.f / DM) + EPS);
        f32x4* o = (f32x4*)(F.out + (m < MP ? O_YP + (size_t)m * DM : O_YS + (size_t)(m - MP) * DM)) + lane;
#pragma unroll
        for (int j = 0; j < 8; ++j) o[64 * j] = xr[64 * j] + v[j] * rs * g3[64 * j];
    }
}

constexpr int N_PHASES = 11;
struct Args { const void* in[N_IN]; float* out; unsigned char* ws; int ph_lo, ph_hi, pad0, pad1; };
__global__ void __launch_bounds__(NTHR, 2) hybrid_fwd(Args args) {
    extern __shared__ __attribute__((aligned(16))) unsigned char lds[];
    Frame F;
    F.lds = (LAS unsigned char*)lds;
    F.tid = threadIdx.x; F.lane = F.tid & 63; F.wave = __builtin_amdgcn_readfirstlane(F.tid >> 6);
    F.G = gridDim.x; { const int bx = blockIdx.x; F.vcu = (F.G % 8 == 0) ? (bx % 8) * (F.G / 8) + bx / 8 : bx; }
#pragma unroll
    for (int i = 0; i < N_IN; ++i) F.in[i] = (const float*)args.in[i];
    F.pt = (const int*)args.in[I_PT]; F.out = args.out; F.ws = args.ws;
    unsigned* ctl = (unsigned*)(F.ws + WS_CTL);
    for (int u = F.tid; u < (LDS_BYTES - LDSCTL_OFF) / 4; u += NTHR) ((LAS unsigned*)(F.lds + LDSCTL_OFF))[u] = 0u;
    __syncthreads();
    const int lo = args.ph_lo, hi = args.ph_hi;
    XcdBarrier bar; bar.bar = ctl + CW_BAR; bar.x = 0; bar.st = nullptr;
    if (hi - lo > 1) bar = xcd_barrier_post(ctl + CW_BAR, (volatile LAS unsigned*)(F.lds + MISC_OFF) + 8);
#ifndef PH3_MASK
#define PH3_MASK 15
#endif
#ifndef PH_MASK
#define PH_MASK 0x7ff
#endif
#define IN(k) (((PH_MASK >> (k)) & 1) && lo <= (k) && (k) < hi)
#define SEAM(k) do { if (IN(k) && IN((k) + 1)) xcd_barrier(bar); } while (0)
    LAS unsigned char* ring = F.lds;

    if (IN(0)) { ph0_prologue(F); } SEAM(0);
    if (IN(1)) {
        pg8::Gemm gm{wsp<bf16>(F, WS_XN), wsp<bf16>(F, WS_WIN), MT, NPROJ, DM}; pg8::StaticOrder S; S.init(MT, NPROJ, F.G, (int)blockIdx.x);
        EpiProj E{wsp<bf16>(F, WS_QB), F.out, wsp<bf16>(F, WS_KB), wsp<bf16>(F, WS_VT), wsp<float>(F, WS_ZF), wsp<float>(F, WS_XBC), wsp<float>(F, WS_GATE), wsp<float>(F, WS_DTR)};
        pg8::gemm_phase<EpiProj, pg8::StaticOrder, true, true>(ring, gm, S, E);
    } SEAM(1);
    if (IN(2)) { for (int u = F.vcu; u < NUNIT; u += F.G) compress_unit(F, u); ssm_pre(F); } SEAM(2);
    if (IN(3)) {
        { const float* LUT = wsp<float>(F, WS_LUT); LAS float* l = (LAS float*)(F.lds + LUT_OFF); for (int i = F.tid; i < 2048; i += NTHR) l[i] = LUT[i]; }
        __syncthreads();
        if (PH3_MASK & 1) for (int it = F.vcu; it < 256; it += F.G) ssm_item(F, it);
        if (PH3_MASK & 2) { volatile LAS float* scr = (volatile LAS float*)(F.lds + F.wave * 4096); volatile LAS float* ost = (volatile LAS float*)(F.lds + 32768 + F.wave * 8192);
          for (int u = F.vcu * NWAVES + F.wave; u < 2048; u += F.G * NWAVES) { attn_prompt_unit(F, u, scr, ost); attn_prompt_unit(F, 4095 - u, scr, ost); } }
        __syncthreads();
        if (PH3_MASK & 4) for (int u = F.vcu; u < 512; u += F.G) attn_sample_unit(F, u);
        if (PH3_MASK & 8) for (int it = 256 + F.vcu; it < 256 + 8192; it += F.G) ssm_item(F, it);
    } SEAM(3);
    if (IN(4)) { ssm_post(F); } SEAM(4);
    if (IN(5)) {
        pg8::Gemm gm{wsp<bf16>(F, WS_MIX), wsp<bf16>(F, WS_WOUT), MT, DM, DM}; pg8::StaticOrder S; S.init(MT, DM, F.G, (int)blockIdx.x);
        EpiF32 E{wsp<float>(F, WS_MIXO), DM};
        pg8::gemm_phase<EpiF32, pg8::StaticOrder, true, true>(ring, gm, S, E);
    } SEAM(5);
    if (IN(6)) { norm1(F); } SEAM(6);
    if (IN(7)) {
        pg8::Gemm gm{wsp<bf16>(F, WS_XN), wsp<bf16>(F, WS_WG), MT, DFFP, DM}; pg8::StaticOrder S; S.init(MT, DFFP, F.G, (int)blockIdx.x);
        EpiGate E{wsp<bf16>(F, WS_GP), F.out};
        pg8::gemm_phase<EpiGate, pg8::StaticOrder, true, true>(ring, gm, S, E);
    } SEAM(7);
    if (IN(8)) {
        pg8::Gemm gm{wsp<bf16>(F, WS_XN), wsp<bf16>(F, WS_WU), MT, DFFP, DM}; pg8::StaticOrder S; S.init(MT, DFFP, F.G, (int)blockIdx.x);
        EpiUp E{wsp<bf16>(F, WS_GP), wsp<bf16>(F, WS_ACT), F.in[I_DWW], F.in[I_DWB], F.in[I_FCONV]};
        pg8::gemm_phase<EpiUp, pg8::StaticOrder, true, true>(ring, gm, S, E);
    } SEAM(8);
    if (IN(9)) {
        pg8::Gemm gm{wsp<bf16>(F, WS_ACT), wsp<bf16>(F, WS_WD), MT, DM, DFFP}; pg8::StaticOrder S; S.init(MT, DM, F.G, (int)blockIdx.x);
        EpiF32 E{wsp<float>(F, WS_FFN), DM};
        pg8::gemm_phase<EpiF32, pg8::StaticOrder, true, true>(ring, gm, S, E);
    } SEAM(9);
    if (IN(10)) { norm2(F); }
#undef IN
#undef SEAM
}

extern "C" void kernel_launch(void* const* d_in, const int* in_sizes, int n_in, void* d_out, int out_size, void* d_ws, size_t ws_size, hipStream_t stream) {
    static int grid = 0;
    if (grid == 0) {
        if (n_in != N_IN || (size_t)out_size != O_END || ws_size < WS_END) { fprintf(stderr, "kernel_launch: unexpected shapes (n_in %d, out %d, ws %zu)\n", n_in, out_size, ws_size); grid = -1; return; }
        int dev = 0, cus = 0;
        if (hipGetDevice(&dev) != hipSuccess || hipDeviceGetAttribute(&cus, hipDeviceAttributeMultiprocessorCount, dev) != hipSuccess) { grid = -1; return; }
        if (hipFuncSetAttribute((const void*)hybrid_fwd, hipFuncAttributeMaxDynamicSharedMemorySize, LDS_BYTES) != hipSuccess) { fprintf(stderr, "kernel_launch: hipFuncSetAttribute failed\n"); grid = -1; return; }
        int per_cu = 0;
        if (hipOccupancyMaxActiveBlocksPerMultiprocessor(&per_cu, (const void*)hybrid_fwd, NTHR, LDS_BYTES) != hipSuccess || per_cu < 1) fprintf(stderr, "kernel_launch: occupancy query says %d\n", per_cu);
        (void)hipGetLastError();
        grid = cus;
    }
    if (grid < 0) return;
    (void)hipMemsetAsync((char*)d_ws + WS_CTL, 0, CTL_ZERO_BYTES, stream);
    Args a{};
    for (int i = 0; i < N_IN; ++i) a.in[i] = d_in[i];
    a.out = (float*)d_out; a.ws = (unsigned char*)d_ws;
#if MK_ONE_LAUNCH
    a.ph_lo = 0; a.ph_hi = N_PHASES;
    hipLaunchKernelGGL(hybrid_fwd, dim3(grid), dim3(NTHR), LDS_BYTES, stream, a);
#else
    for (int p = 0; p < N_PHASES; ++p) { a.ph_lo = p; a.ph_hi = p + 1; hipLaunchKernelGGL(hybrid_fwd, dim3(grid), dim3(NTHR), LDS_BYTES, stream, a); }
#endif
}
```

```cpp
#include <hip/hip_runtime.h>
#include <cstdio>
#include <cstdint>
#ifndef MK_ONE_LAUNCH
#define MK_ONE_LAUNCH 1
#endif
#define DBL_DEFAULT 0
#ifndef DBL
#define DBL DBL_DEFAULT
#endif
#define PROBE_PH_DEFAULT -1
#ifndef PROBE_PH
#define PROBE_PH PROBE_PH_DEFAULT
#endif
#ifndef PROBE_AMP
#define PROBE_AMP 1
#endif
#define BWPROBE 0
namespace pg8 {
#define PG8_LAS __attribute__((address_space(3)))
typedef unsigned short bf16_t;
typedef short bf16x8 __attribute__((ext_vector_type(8)));
typedef float f32x4 __attribute__((ext_vector_type(4)));
typedef unsigned u32x4 __attribute__((ext_vector_type(4)));
constexpr int BM = 256, BK = 64, HALF = 128, HTB = HALF * BK * 2  , STAGE_BYTES = 8 * HTB, NXCD = 8, WGM = 8;

__host__ __device__ __forceinline__ int lds_byte(int r, int c) { const int st = (r >> 4) * 2 + (c >> 5), rr = r & 15, cc = c & 31, ob = rr * 64 + cc * 2; return st * 1024 + (ob ^ (((ob >> 9) & 1) << 5)); }
__host__ __device__ __forceinline__ void stage_rc(int b, int& R, int& C) { const int st = b / 1024, sb = b % 1024, swz = sb ^ (((sb >> 9) & 1) << 5); R = (st >> 1) * 16 + swz / 64; C = (st & 1) * 32 + (swz % 64) / 2; }
__host__ __device__ __forceinline__ int perm32(int rho) { const int n = rho >> 4, i = rho & 15; return 8 * (i >> 2) + 4 * n + (i & 3); }

struct Unit { int pm, pn; };
struct Gemm { const bf16_t* A; const bf16_t* Bt; int M, N, K, Kl; };

struct StaticOrder {
    int nM, nN, nwg, G, c;
    __host__ __device__ __forceinline__ void init(int M, int N, int G_, int c_) { nM = M / BM; nN = N / BM; nwg = nM * nN; G = G_; c = c_; }
    __host__ __device__ __forceinline__ bool next(int i, Unit& u) const {
        const long L = (long)i * G + c; if (L >= nwg) return false;
        int wgid = (int)L; { const int q = nwg / NXCD, r = nwg % NXCD, xcd = wgid % NXCD, off = wgid / NXCD; wgid = (xcd < r ? xcd * (q + 1) : r * (q + 1) + (xcd - r) * q) + off; }
        const int nig = WGM * nN, gid = wgid / nig, fm = gid * WGM, gsz = (nM - fm) < WGM ? (nM - fm) : WGM;
        u.pm = fm + ((wgid % nig) % gsz); u.pn = (wgid % nig) / gsz; return true;
    }
    __device__ __forceinline__ void a_ready(const Unit&) const {}
    __device__ __forceinline__ void done(const Unit&) const {}
};

template <class Epi, class Sched, bool ALIGN_EPI = false, bool SP2 = false>
__device__ __forceinline__ void gemm_phase(PG8_LAS unsigned char* lds, const Gemm g, const Sched& S, const Epi& E) {
    const int tid = threadIdx.x, wid = __builtin_amdgcn_readfirstlane(tid >> 6), lane = tid & 63, wr = wid >> 2, wc = wid & 3, fr = lane & 15, fq = lane >> 4;
    const int K = g.K, nt = g.Kl / BK;
    unsigned voffA[2], voffB[2];
#pragma unroll
    for (int i = 0; i < 2; ++i) { int R, C; stage_rc(tid * 16 + i * 8192, R, C); const int Rb = Epi::PERM ? ((R & ~31) + perm32(R & 31)) : R;
        voffA[i] = (unsigned)(R * K + C) * 2u; voffB[i] = (unsigned)(Rb * K + C) * 2u; }
    const size_t kstep = (size_t)(BK * 2);
    const size_t hstep = (size_t)HALF * K * 2;
    const size_t tstep = 2 * hstep;
    const unsigned ldsw = (unsigned)wid * 1024u;
    const int aoff = lds_byte(wr * 64 + fr, fq * 8), boff = lds_byte(wc * 32 + fr, fq * 8);
#define PG8_SA(b, h) (((b) * 2 + (h)) * HTB)
#define PG8_SB(b, h) ((4 + (b) * 2 + (h)) * HTB)
#define PG8_STAGE(bufoff, gbase, voff) do { _Pragma("unroll") for (int _i = 0; _i < 2; ++_i) \
        __builtin_amdgcn_global_load_lds((const unsigned*)((const char*)(gbase) + (voff)[_i]), (PG8_LAS unsigned*)(lds + (bufoff) + ldsw + _i * 8192), 16, 0, 0); } while (0)
#define PG8_LDA(dst, b, h) do { _Pragma("unroll") for (int m = 0; m < 4; ++m) _Pragma("unroll") for (int k = 0; k < 2; ++k) dst[m][k] = *(const PG8_LAS bf16x8*)(lds + PG8_SA(b, h) + aoff + m * 2048 + k * 1024); } while (0)
#define PG8_LDB(dst, b, h) do { _Pragma("unroll") for (int n = 0; n < 2; ++n) _Pragma("unroll") for (int k = 0; k < 2; ++k) dst[n][k] = *(const PG8_LAS bf16x8*)(lds + PG8_SB(b, h) + boff + n * 2048 + k * 1024); } while (0)
#define PG8_MMA(ai, bj, At, Bt) do { __builtin_amdgcn_s_setprio(1); _Pragma("unroll") for (int m = 0; m < 4; ++m) _Pragma("unroll") for (int n = 0; n < 2; ++n) _Pragma("unroll") for (int k = 0; k < 2; ++k) \
        acc[ai][bj][m][n] = __builtin_amdgcn_mfma_f32_16x16x32_bf16(Bt[n][k], At[m][k], acc[ai][bj][m][n], 0, 0, 0); __builtin_amdgcn_s_setprio(0); } while (0)
#define PG8_WAIT_V(n) asm volatile("s_waitcnt vmcnt(" #n ")" ::: "memory")
#define PG8_WAIT_L(n) asm volatile("s_waitcnt lgkmcnt(" #n ")" ::: "memory")
#define PG8_BAR __builtin_amdgcn_s_barrier()
#define PG8_SCHED __builtin_amdgcn_sched_barrier(0)
    Unit cur, nxt; int ui = 0;
    if (!S.next(0, cur)) return;
    f32x4 acc[2][2][4][2];
#pragma unroll
    for (int a = 0; a < 2; ++a)
#pragma unroll
        for (int b = 0; b < 2; ++b)
#pragma unroll
            for (int m = 0; m < 4; ++m)
#pragma unroll
                for (int n = 0; n < 2; ++n) acc[a][b][m][n] = (f32x4){0.f, 0.f, 0.f, 0.f};
    bf16x8 At[4][2], B0[2][2], B1[2][2];
    const char* cA = (const char*)g.A + (size_t)cur.pm * tstep; const char* cB = (const char*)g.Bt + (size_t)cur.pn * tstep;
    S.a_ready(cur);
    if constexpr (SP2) {
        PG8_STAGE(PG8_SB(0, 0), cB, voffB); PG8_STAGE(PG8_SB(0, 1), cB + hstep, voffB); PG8_STAGE(PG8_SA(0, 0), cA, voffA); PG8_STAGE(PG8_SA(0, 1), cA + hstep, voffA);
        if (wr == 1) PG8_BAR;
        PG8_WAIT_V(2); PG8_BAR;
        PG8_STAGE(PG8_SB(1, 0), cB + kstep, voffB); PG8_STAGE(PG8_SA(1, 0), cA + kstep, voffA); PG8_STAGE(PG8_SB(1, 1), cB + hstep + kstep, voffB);
        PG8_WAIT_V(6); PG8_BAR;
    } else {
        PG8_STAGE(PG8_SB(0, 0), cB, voffB); PG8_STAGE(PG8_SA(0, 0), cA, voffA); PG8_STAGE(PG8_SB(0, 1), cB + hstep, voffB); PG8_STAGE(PG8_SA(0, 1), cA + hstep, voffA);
        if (wr == 1) PG8_BAR;
        PG8_WAIT_V(4); PG8_BAR;
        PG8_STAGE(PG8_SB(1, 0), cB + kstep, voffB); PG8_STAGE(PG8_SA(1, 0), cA + kstep, voffA); PG8_STAGE(PG8_SB(1, 1), cB + hstep + kstep, voffB);
        PG8_WAIT_V(6); PG8_BAR;
    }
    for (;;) {
        const bool has_next = S.next(ui + 1, nxt);
        const char* nA = has_next ? (const char*)g.A + (size_t)nxt.pm * tstep : cA; const char* nB = has_next ? (const char*)g.Bt + (size_t)nxt.pn * tstep : cB;
        for (int t = 0; t < nt; t += 2) {
            const bool last = (t == nt - 2);
            const char* a1 = cA + (size_t)(t + 1) * kstep;
            const char* a2 = last ? nA : cA + (size_t)(t + 2) * kstep; const char* b2 = last ? nB : cB + (size_t)(t + 2) * kstep;
            const char* a3 = a2 + kstep; const char* b3 = b2 + kstep;
            if (last && has_next) S.a_ready(nxt);
            if constexpr (SP2) {
            PG8_LDB(B0, 0, 0); PG8_LDB(B1, 0, 1); PG8_SCHED; PG8_LDA(At, 0, 0); PG8_STAGE(PG8_SA(1, 1), a1 + hstep, voffA);
            PG8_WAIT_V(8); PG8_WAIT_L(0); PG8_BAR; PG8_MMA(0, 0, At, B0); PG8_MMA(0, 1, At, B1); PG8_BAR; PG8_SCHED;
            PG8_LDA(At, 0, 1); PG8_STAGE(PG8_SB(0, 0), b2, voffB); PG8_STAGE(PG8_SB(0, 1), b2 + hstep, voffB); PG8_STAGE(PG8_SA(0, 0), a2, voffA);
            PG8_WAIT_V(8); PG8_WAIT_L(0); PG8_BAR; PG8_MMA(1, 0, At, B0); PG8_MMA(1, 1, At, B1); PG8_BAR; PG8_SCHED;
            PG8_LDB(B0, 1, 0); PG8_LDB(B1, 1, 1); PG8_SCHED; PG8_LDA(At, 1, 0); PG8_STAGE(PG8_SA(0, 1), a2 + hstep, voffA);
            PG8_WAIT_V(8); PG8_WAIT_L(0); PG8_BAR; PG8_MMA(0, 0, At, B0); PG8_MMA(0, 1, At, B1); PG8_BAR; PG8_SCHED;
            PG8_LDA(At, 1, 1); PG8_STAGE(PG8_SB(1, 0), b3, voffB); PG8_STAGE(PG8_SB(1, 1), b3 + hstep, voffB); PG8_STAGE(PG8_SA(1, 0), a3, voffA);
            PG8_WAIT_V(8); PG8_WAIT_L(0); PG8_BAR; PG8_MMA(1, 0, At, B0); PG8_MMA(1, 1, At, B1); PG8_BAR; PG8_SCHED;
            } else {
            PG8_LDB(B0, 0, 0); PG8_SCHED; PG8_LDA(At, 0, 0); PG8_STAGE(PG8_SA(1, 1), a1 + hstep, voffA);
            PG8_WAIT_L(8); PG8_BAR; PG8_WAIT_L(0); PG8_MMA(0, 0, At, B0); PG8_BAR; PG8_SCHED;
            PG8_LDB(B1, 0, 1); PG8_STAGE(PG8_SB(0, 0), b2, voffB);
            PG8_BAR; PG8_WAIT_L(0); PG8_MMA(0, 1, At, B1); PG8_BAR;
            PG8_LDA(At, 0, 1); PG8_STAGE(PG8_SA(0, 0), a2, voffA);
            PG8_BAR; PG8_WAIT_L(0); PG8_MMA(1, 0, At, B0); PG8_BAR; PG8_SCHED;
            PG8_STAGE(PG8_SB(0, 1), b2 + hstep, voffB);
            PG8_WAIT_V(6); PG8_BAR; PG8_MMA(1, 1, At, B1); PG8_BAR;
            PG8_LDB(B0, 1, 0); PG8_SCHED; PG8_LDA(At, 1, 0); PG8_STAGE(PG8_SA(0, 1), a2 + hstep, voffA);
            PG8_WAIT_L(8); PG8_BAR; PG8_WAIT_L(0); PG8_MMA(0, 0, At, B0); PG8_BAR; PG8_SCHED;
            PG8_LDB(B1, 1, 1); PG8_STAGE(PG8_SB(1, 0), b3, voffB);
            PG8_BAR; PG8_WAIT_L(0); PG8_MMA(0, 1, At, B1); PG8_BAR;
            PG8_LDA(At, 1, 1); PG8_STAGE(PG8_SA(1, 0), a3, voffA);
            PG8_BAR; PG8_WAIT_L(0); PG8_MMA(1, 0, At, B0); PG8_BAR; PG8_SCHED;
            PG8_STAGE(PG8_SB(1, 1), b3 + hstep, voffB);
            PG8_WAIT_V(6); PG8_BAR; PG8_MMA(1, 1, At, B1); PG8_BAR;
            }
        }
        if constexpr (ALIGN_EPI) { if (wr == 0) PG8_BAR; }
        if constexpr (!Epi::AFTER_DRAIN) { E(acc, cur, wr, wc, fr, fq); S.done(cur); }
        if (!has_next) break;
#pragma unroll
        for (int a = 0; a < 2; ++a)
#pragma unroll
            for (int b = 0; b < 2; ++b)
#pragma unroll
                for (int m = 0; m < 4; ++m)
#pragma unroll
                    for (int n = 0; n < 2; ++n) acc[a][b][m][n] = (f32x4){0.f, 0.f, 0.f, 0.f};
        cur = nxt; cA = nA; cB = nB; ++ui;
        if constexpr (ALIGN_EPI) { if (wr == 1) PG8_BAR; }
    }
    PG8_WAIT_V(0);
    if constexpr (!ALIGN_EPI) { if (wr == 0) PG8_BAR; }
    PG8_BAR;
    if constexpr (Epi::AFTER_DRAIN) { E.fused(acc, cur, wr, wc, fr, fq, lds, wid, lane); S.done(cur); }
#undef PG8_SA
#undef PG8_SB
#undef PG8_STAGE
#undef PG8_LDA
#undef PG8_LDB
#undef PG8_MMA
#undef PG8_WAIT_V
#undef PG8_WAIT_L
#undef PG8_BAR
#undef PG8_SCHED
}
}

#define LAS __attribute__((address_space(3)))
#define DI __device__ __forceinline__
typedef unsigned short bf16;
typedef short bf16x8 __attribute__((ext_vector_type(8)));
typedef short s16x4 __attribute__((ext_vector_type(4)));
typedef float f32x4 __attribute__((ext_vector_type(4)));
typedef float f32x2 __attribute__((ext_vector_type(2)));
typedef float f32x16 __attribute__((ext_vector_type(16)));
typedef unsigned u32x4 __attribute__((ext_vector_type(4)));
typedef unsigned u32x2 __attribute__((ext_vector_type(2)));
typedef __bf16 bf16x2_t __attribute__((ext_vector_type(2)));

constexpr int NWAVES = 8, NTHR = 512;
constexpr int DM = 2048, BP = 4, TP = 2048, BS = 128, TS = 8, MP = BP * TP, MS = BS * TS, MT = MP + MS;
constexpr int NPROJ = 5888, DFF = 5504, DFFP = 5632, INW = 5696;
constexpr int NUNIT = 16 + 512;
constexpr float EPS = 1e-6f, NEGF = -1e30f, TINYF = 1e-30f;
enum { I_XP = 0, I_XS, I_CKV, I_CWIN, I_SCONV, I_SSM, I_FCONV, I_PT, I_REL, I_LNPRE, I_WIN, I_CPE, I_CW1, I_CB1, I_CW2, I_CB2, I_SCW, I_SCB, I_DTB, I_ALOG, I_SD, I_SNG,
       I_WOUT, I_LNPOST, I_LNFPRE, I_WG, I_WU, I_DWW, I_DWB, I_WD, I_LNFPOST, N_IN };
constexpr size_t O_YP = 0, O_YS = 16777216, O_KVP = 18874368, O_KVS = 27262976, O_WINP = 28311552, O_WINS = 29360128, O_SCP = 62914560, O_SCS = 62939136,
                 O_SSP = 63725568, O_SSS = 64249856, O_FCP = 81027072, O_FCS = 81071104, O_END = 82480128;
constexpr size_t MiB = 1u << 20;
constexpr size_t WS_CTL = 0, CTL_ZERO_BYTES = 1 * MiB;
constexpr size_t WS_WIN = 2 * MiB, WS_WOUT = 26 * MiB, WS_WG = 34 * MiB, WS_WU = 56 * MiB, WS_WD = 78 * MiB, WS_W12 = 100 * MiB;
constexpr size_t WS_W2T = 101 * MiB, WS_CBP = 101 * MiB + 65536, WS_LUT = 101 * MiB + 131072;
constexpr size_t WS_XN = 102 * MiB, WS_QB = 138 * MiB, WS_KB = 156 * MiB, WS_VT = 164 * MiB, WS_ZF = 172 * MiB, WS_XBC = 208 * MiB;
constexpr size_t WS_GATE = 280 * MiB, WS_DTR = 282 * MiB, WS_XBCC = 284 * MiB, WS_DT = 356 * MiB, WS_KCK = 358 * MiB, WS_KCVT = 368 * MiB;
constexpr size_t WS_YSSM = 378 * MiB, WS_MIX = 414 * MiB, WS_MIXO = 450 * MiB, WS_X1 = 522 * MiB, WS_GP = 594 * MiB, WS_ACT = 694 * MiB, WS_FFN = 794 * MiB, WS_SC = 868 * MiB, WS_HPREV = 900 * MiB, WS_ACUM = 916 * MiB, WS_ATOT = 917 * MiB, WS_SLAB = 918 * MiB, WS_UP = 1206 * MiB, WS_HALO = 1306 * MiB, WS_FIXG = 1308 * MiB, WS_FIXU = 1310 * MiB, WS_END = 1312 * MiB;
constexpr int CW_BAR = 4096, CW_FLAG6 = 8192, CW_FLAG10 = 8192 + 512;
constexpr int RING_BYTES = 131072, LDSCTL_OFF = RING_BYTES, MISC_OFF = LDSCTL_OFF + 320, PTAB_OFF = RING_BYTES + 512, LUT_OFF = RING_BYTES + 1024, LDS_BYTES = 147456;
static_assert(LUT_OFF + 8192 <= LDS_BYTES, "LDS map");

DI unsigned pk2(float lo, float hi) { f32x2 v = {lo, hi}; bf16x2_t b = __builtin_convertvector(v, bf16x2_t); return __builtin_bit_cast(unsigned, b); }
DI bf16x8 cvt8(f32x4 a, f32x4 b) { u32x4 p = {pk2(a.x, a.y), pk2(a.z, a.w), pk2(b.x, b.y), pk2(b.z, b.w)}; return __builtin_bit_cast(bf16x8, p); }
DI float bf2f(unsigned short u) { return __uint_as_float(((unsigned)u) << 16); }
DI float sigmoidf_(float x) { return __builtin_amdgcn_rcpf(1.0f + __builtin_amdgcn_exp2f(-1.4426950408889634f * x)); }
DI float siluf_(float x) { return x * sigmoidf_(x); }
DI float gelu_tanh(float x) { const float u2 = (-2.0f * 0.7978845608028654f * 1.4426950408889634f) * (x + 0.044715f * x * x * x); return x * __builtin_amdgcn_rcpf(1.0f + __builtin_amdgcn_exp2f(u2)); }
DI float softplusf_(float x) { return x > 20.f ? x : log1pf(__expf(x)); }
DI int crow(int reg, int h) { return (reg & 3) + 8 * (reg >> 2) + 4 * h; }
DI float wave_sum(float v) {
#pragma unroll
    for (int o = 1; o < 64; o <<= 1) v += __shfl_xor(v, o);
    return v;
}
#define MFMA32(a, b, c) __builtin_amdgcn_mfma_f32_32x32x16_bf16((a), (b), (c), 0, 0, 0)
#define VM_WAIT() asm volatile("s_waitcnt vmcnt(0)" ::: "memory")
#define LDS_WAIT() asm volatile("s_waitcnt lgkmcnt(0)" ::: "memory")

struct Frame {
    LAS unsigned char* lds;
    int tid, lane, wave, vcu, G;
    LAS unsigned* ptab; const int* pt;
    float* out; unsigned char* ws;
};
template <class T> DI T* wsp(const Frame& F, size_t off) { return (T*)(F.ws + off); }
DI const float* inp(const Frame& F, int k) { const unsigned lo = __builtin_amdgcn_readfirstlane(F.ptab[2 * k]), hi = __builtin_amdgcn_readfirstlane(F.ptab[2 * k + 1]); const __attribute__((address_space(1))) float* gp = (const __attribute__((address_space(1))) float*)(((unsigned long long)hi << 32) | lo); return (const float*)gp; }

template <int MAP> DI int rowmap(int n) {
    if (MAP == 0) return n;
    if (MAP == 2) return 256 * (n >> 7) + (n & 127);
    if (MAP == 3) return 256 * (n >> 7) + 128 + (n & 127);
    if (n < 2560) return n;
    if (n < 2608) return 5632 + (n - 2560);
    if (n < 3632) return 2560 + (n - 2608);
    if (n < 5680) return 3584 + (n - 3632);
    return 5632 + 48 + (n - 5680);
}
template <int MAP> DI void transpose_item(const float* W, int N, bf16* WT, int dst_pitch, int row_off, LAS float* scr, int item, int lane) {
    const int nblk = N / 32, kb = item / nblk, nb = item % nblk, k0 = 64 * kb, n0 = 32 * nb;
    float wv[32];
#pragma unroll
    for (int i = 0; i < 32; ++i) wv[i] = W[(size_t)(k0 + 2 * i + (lane >> 5)) * N + n0 + (lane & 31)];
#pragma unroll
    for (int i = 0; i < 32; ++i) scr[(2 * i + (lane >> 5)) * 33 + (lane & 31)] = wv[i];
    LDS_WAIT(); asm volatile("" ::: "memory");
    const int c = lane & 7;
#pragma unroll
    for (int j = 0; j < 4; ++j) { const int n = (lane >> 3) + 8 * j; const LAS float* s = scr + (8 * c) * 33 + n;
        u32x4 o; o.x = pk2(s[0 * 33], s[1 * 33]); o.y = pk2(s[2 * 33], s[3 * 33]); o.z = pk2(s[4 * 33], s[5 * 33]); o.w = pk2(s[6 * 33], s[7 * 33]);
        if (MAP == 4) { const int nn = row_off + n0 + n, kk = k0 + 8 * c;
            *(u32x4*)(WT + ((size_t)(((nn >> 5) * (dst_pitch >> 4) + (kk >> 4)) * 64 + ((kk >> 3) & 1) * 32 + (nn & 31))) * 8) = o; }
        else *(u32x4*)(WT + (size_t)(row_off + rowmap<MAP>(n0 + n)) * dst_pitch + k0 + 8 * c) = o; }
    LDS_WAIT(); asm volatile("" ::: "memory");
}
DI void rmsnorm_row_bf16(const float* xrow, const float* g, bf16* orow, int lane) {
    const f32x4* xr = (const f32x4*)xrow + lane; const f32x4* gr = (const f32x4*)g + lane;
    f32x4 v[8]; float s = 0.f;
#pragma unroll
    for (int j = 0; j < 8; ++j) { v[j] = xr[64 * j]; s += (v[j].x * v[j].x + v[j].y * v[j].y) + (v[j].z * v[j].z + v[j].w * v[j].w); }
    const float rs = 1.0f / sqrtf(wave_sum(s) * (1.f / DM) + EPS);
    u32x2* o8 = (u32x2*)orow + lane;
#pragma unroll
    for (int j = 0; j < 8; ++j) { const f32x4 gg = gr[64 * j]; u32x2 w; w.x = pk2(v[j].x * rs * gg.x, v[j].y * rs * gg.y); w.y = pk2(v[j].z * rs * gg.z, v[j].w * rs * gg.w); o8[64 * j] = w; }
}
DI int rel_bucket(int n) {
    if (n < 16) return n;
    const int v = 16 + (int)(logf((float)n * (1.0f / 16.0f)) * (16.0f / 2.0794415416798357f));
    return v < 31 ? v : 31;
}
DI void win_copy(Frame& F, int rank, int nranks, int Rc) {
    const f32x4* src = (const f32x4*)inp(F, I_CWIN); f32x4* dst = (f32x4*)(F.out + O_WINS);
    for (int ii = rank * NTHR + F.tid; ii < BS * 504 * 128 * Rc; ii += nranks * NTHR) { const int i = ii % (BS * 504 * 128); const int b = i / (504 * 128), rr = i % (504 * 128); dst[(size_t)b * 512 * 128 + rr] = src[(size_t)b * 512 * 128 + 8 * 128 + rr]; }
}
DI void ph0_prologue(Frame& F, int Ra, int Rc, int Re) {
    LAS float* scr = (LAS float*)(F.lds + F.wave * 16384);
    const int gw = F.vcu * NWAVES + F.wave, NGW = F.G * NWAVES, lane = F.lane;
    bf16* WINT = wsp<bf16>(F, WS_WIN); bf16* WOUTT = wsp<bf16>(F, WS_WOUT); bf16* WGT = wsp<bf16>(F, WS_WG); bf16* WUT = wsp<bf16>(F, WS_WU); bf16* WDT = wsp<bf16>(F, WS_WD);
    bf16* W12T = wsp<bf16>(F, WS_W12); bf16* W2T = wsp<bf16>(F, WS_W2T);
    constexpr int I_IN = (DM / 64) * (INW / 32), I_OUT = (DM / 64) * (DM / 32), I_G = (DM / 64) * (DFF / 32), I_D = (DFF / 64) * (DM / 32), I_12 = (1024 / 64) * (128 / 32), I_2 = (128 / 64) * (64 / 32);
    constexpr int NITEMS = I_IN + I_OUT + 2 * I_G + I_D + 4 * I_12 + 2 * I_2;
    for (int it = gw; it < NITEMS * Ra; it += NGW) {
        int r = it % NITEMS;
        if (r < I_IN) { transpose_item<1>(inp(F, I_WIN), INW, WINT, DM, 0, scr, r, lane); continue; } r -= I_IN;
        if (r < I_OUT) { transpose_item<0>(inp(F, I_WOUT), DM, WOUTT, DM, 0, scr, r, lane); continue; } r -= I_OUT;
        if (r < I_G) { transpose_item<2>(inp(F, I_WG), DFF, WGT, DM, 0, scr, r, lane); continue; } r -= I_G;
        if (r < I_G) { transpose_item<3>(inp(F, I_WU), DFF, WGT, DM, 0, scr, r, lane); continue; } r -= I_G;
        if (r < I_D) { transpose_item<0>(inp(F, I_WD), DM, WDT, DFFP, 0, scr, r, lane); continue; } r -= I_D;
        if (r < 4 * I_12) { const int q = r / I_12, kv = q >> 1, hf = q & 1;
            transpose_item<4>(inp(F, I_CW1) + (size_t)kv * 2048 * 128 + (size_t)hf * 1024 * 128, 128, W12T + (size_t)kv * 256 * 1024, 1024, hf * 128, scr, r % I_12, lane); continue; } r -= 4 * I_12;
        { const int kv = r / I_2; transpose_item<0>(inp(F, I_CW2) + (size_t)kv * 128 * 64, 64, W2T + (size_t)kv * 64 * 128, 128, 0, scr, r % I_2, lane); }
    }
    {
        const int gt = F.vcu * NTHR + F.tid, NGT = F.G * NTHR; const u32x4 z = {0u, 0u, 0u, 0u};
        for (int i = gt; i < 192 * 256; i += NGT) ((u32x4*)(WINT + (size_t)5696 * DM))[i] = z;
        for (int i = gt; i < 256 * 256; i += NGT) ((u32x4*)(WGT + (size_t)(2 * DFF) * DM))[i] = z;
        for (int i = gt; i < 2048 * 16; i += NGT) { const int row = i >> 4, c = i & 15; *(u32x4*)(WDT + (size_t)row * DFFP + DFF + 8 * c) = z; }
        { bf16* ACT = wsp<bf16>(F, WS_ACT); for (int i = gt; i < MT * 16; i += NGT) { const int row = i >> 4, c = i & 15; *(u32x4*)(ACT + (size_t)row * DFFP + DFF + 8 * c) = z; } }
        float* LUT = wsp<float>(F, WS_LUT);
        for (int i = gt; i < 2048; i += NGT) { const int dist = i >> 4, hd = i & 15; LUT[i] = inp(F, I_REL)[rel_bucket(dist) * 16 + hd]; }
    }
    {
        float* CBP = wsp<float>(F, WS_CBP); LAS float* red = (LAS float*)(F.lds + 12288);
        for (int it = F.vcu; it < 32; it += F.G) { const int kv = it >> 4, part = (it >> 1) & 7, hh = (it & 1) * 64 + lane;
            const float* pe = inp(F, I_CPE) + (size_t)kv * 2048; const float* w1 = inp(F, I_CW1) + (size_t)kv * 2048 * 128; float s = 0.f;
            const int k0 = part * 256 + F.wave * 32;
#pragma unroll
            for (int k = 0; k < 32; ++k) s += pe[k0 + k] * w1[(size_t)(k0 + k) * 128 + hh];
            red[F.wave * 64 + lane] = s;
            __syncthreads();
            if (F.wave == 0) { float t = 0.f;
#pragma unroll
                for (int w2 = 0; w2 < 8; ++w2) t += red[w2 * 64 + lane];
                CBP[(kv * 8 + part) * 128 + hh] = t; }
            __syncthreads(); }
    }
    bf16* XN = wsp<bf16>(F, WS_XN);
    for (int mm = gw; mm < MT * Re; mm += NGW) { const int m = mm % MT; const float* xr = m < MP ? inp(F, I_XP) + (size_t)m * DM : inp(F, I_XS) + (size_t)(m - MP) * DM; rmsnorm_row_bf16(xr, inp(F, I_LNPRE), XN + (size_t)m * DM, lane); }
}
#define XB_TMO      128
#define XB_XCNT(j)  (256  + 64 * (j))
#define XB_XSUB(j)  (1280 + 64 * (j))
#define XB_XGEN(j)  (2304 + 64 * (j))
#define XB_TOP      3328
#define XB_TOPGEN   3392
#define XCD_BAR_WORDS 3456
#define XB_SPIN_CAP (1u << 18)

__device__ __forceinline__ unsigned xb_ld(unsigned* p)              { return __hip_atomic_load(p, __ATOMIC_RELAXED, __HIP_MEMORY_SCOPE_AGENT); }
__device__ __forceinline__ unsigned xb_add(unsigned* p, unsigned v) { return __hip_atomic_fetch_add(p, v, __ATOMIC_RELAXED, __HIP_MEMORY_SCOPE_AGENT); }
__device__ __forceinline__ unsigned xb_xcc_id() { return (unsigned)__builtin_amdgcn_s_getreg((3 << 11) | 20) & 0xFu; }
#define XB_SPIN(cond, bar) do { unsigned _sp = 0; while (cond) { __builtin_amdgcn_s_sleep(1); \
    if ((++_sp & 255u) == 0u) { if (xb_ld(&(bar)[XB_TMO])) break; if (_sp > XB_SPIN_CAP) { atomicAdd(&(bar)[XB_TMO], 1u); break; } } } } while (0)

struct XcdBarrier {
    unsigned* bar; unsigned x;
    volatile LAS unsigned* st;
};

__device__ __forceinline__ XcdBarrier xcd_barrier_post(unsigned* bar, volatile LAS unsigned* st) {
    XcdBarrier b; b.bar = bar; b.x = xb_xcc_id(); b.st = st;
    if (threadIdx.x == 0) (void)xb_add(&bar[XB_XCNT(b.x)], 1u);
    return b;
}
__device__ __forceinline__ void xcd_barrier_complete(unsigned* bar, unsigned x, unsigned& nloc, unsigned& nx) {
    const unsigned G = gridDim.x * gridDim.y * gridDim.z;
    unsigned sum, cnt, mine, sp = 0u;
    for (;;) {
        sum = 0u; cnt = 0u; mine = 0u;
#pragma unroll
        for (unsigned j = 0; j < 16; ++j) { const unsigned c = xb_ld(&bar[XB_XCNT(j)]); sum += c; cnt += (c > 0u) ? 1u : 0u; mine = (j == x) ? c : mine; }
        if (sum == G) break;
        __builtin_amdgcn_s_sleep(1);
        if ((++sp & 255u) == 0u) { if (xb_ld(&bar[XB_TMO])) break; if (sp > XB_SPIN_CAP) { atomicAdd(&bar[XB_TMO], 1u); break; } }
    }
    nloc = mine > 0u ? mine : 1u; nx = cnt > 0u ? cnt : 1u;
}

__device__ __forceinline__ void xcd_barrier(const XcdBarrier& b) {
    asm volatile("s_waitcnt vmcnt(0)" ::: "memory");
    __syncthreads();
    if (threadIdx.x == 0) {
        unsigned* bar = b.bar;
        __builtin_amdgcn_s_waitcnt(0);
        unsigned nloc = b.st[0], nx = b.st[1];
        if (nloc == 0u) { xcd_barrier_complete(bar, b.x, nloc, nx); b.st[0] = nloc; b.st[1] = nx; }
        const unsigned old = xb_add(&bar[XB_XSUB(b.x)], 1u);
        const unsigned gen = old / nloc;
        if (old + 1u == (gen + 1u) * nloc) {
            __builtin_amdgcn_fence(__ATOMIC_RELEASE, "agent");
            asm volatile("s_waitcnt vmcnt(0)" ::: "memory");
            const unsigned og = xb_add(&bar[XB_TOP], 1u);
            const unsigned tg = og / nx;
            if (og + 1u == (tg + 1u) * nx) xb_add(&bar[XB_TOPGEN], 1u);
            else XB_SPIN(xb_ld(&bar[XB_TOPGEN]) == tg, bar);
            __builtin_amdgcn_fence(__ATOMIC_ACQUIRE, "agent");
            xb_add(&bar[XB_XGEN(b.x)], 1u);
            asm volatile("s_waitcnt vmcnt(0)" ::: "memory");
        } else {
            XB_SPIN(xb_ld(&bar[XB_XGEN(b.x)]) == gen, bar);
            __builtin_amdgcn_fence(__ATOMIC_ACQUIRE, "agent");
            asm volatile("s_waitcnt vmcnt(0)" ::: "memory");
        }
    }
    __syncthreads();
}

struct EpiProj {
    static constexpr bool PERM = false, AFTER_DRAIN = false;
    unsigned char* ws; float* out;
    __device__ __forceinline__ void operator()(const pg8::f32x4 (&acc)[2][2][4][2], const pg8::Unit& u, int wr, int wc, int fr, int fq) const {
        const int pn = u.pn;
        bf16* const QB = (bf16*)(ws + WS_QB); bf16* const KB = (bf16*)(ws + WS_KB); bf16* const VT = (bf16*)(ws + WS_VT); float* const ZF = (float*)(ws + WS_ZF); float* const XBC = (float*)(ws + WS_XBC); float* const GATE = (float*)(ws + WS_GATE); float* const DTR = (float*)(ws + WS_DTR);
#pragma unroll
        for (int ai = 0; ai < 2; ++ai)
#pragma unroll
            for (int m = 0; m < 4; ++m) {
                const int row = u.pm * 256 + ai * 128 + wr * 64 + m * 16 + fr;
                const bool isp = row < MP; const int b = isp ? (row >> 11) : ((row - MP) >> 3); const int t = isp ? (row & 2047) : ((row - MP) & 7);
#pragma unroll
                for (int bj = 0; bj < 2; ++bj)
#pragma unroll
                    for (int n = 0; n < 2; ++n) {
                        const int cl = bj * 128 + wc * 32 + n * 16 + fq * 4; const f32x4 v = acc[ai][bj][m][n];
                        if (pn < 4) { u32x2 w; w.x = pk2(v.x, v.y); w.y = pk2(v.z, v.w); *(u32x2*)(QB + (size_t)row * 1024 + pn * 256 + cl) = w; }
                        else if (pn < 10) { const int slot = pn - 4, g = cl >> 6, d = cl & 63;
                            if (slot < 4) { float* dst = isp ? out + O_KVP + ((size_t)row * 4 + slot) * 256 + cl : out + O_KVS + ((size_t)(row - MP) * 4 + slot) * 256 + cl; *(f32x4*)dst = v; }
                            else { const int s2 = slot - 4;
                                if (isp) { if (t >= TP - 512) *(f32x4*)(out + O_WINP + (((size_t)b * 512 + (t - (TP - 512))) * 2 + s2) * 256 + cl) = v; }
                                else *(f32x4*)(out + O_WINS + (((size_t)b * 512 + 504 + t) * 2 + s2) * 256 + cl) = v; }
                            if (isp && slot >= 2) { const int sl = slot >> 2;
                                if ((slot & 1) == 0) { u32x2 w; w.x = pk2(v.x, v.y); w.y = pk2(v.z, v.w); *(u32x2*)(KB + ((size_t)((b * 2 + sl) * 4 + g) * 2048 + t) * 64 + d) = w; }
                                else { bf16* vp = VT + ((size_t)((b * 2 + sl) * 4 + g) * 64 + d) * 2048 + t; const unsigned p0 = pk2(v.x, v.y), p1 = pk2(v.z, v.w);
                                    vp[0] = (bf16)(p0 & 0xffffu); vp[2048] = (bf16)(p0 >> 16); vp[4096] = (bf16)(p1 & 0xffffu); vp[6144] = (bf16)(p1 >> 16); } } }
                        else if (pn < 14) *(f32x4*)(ZF + (size_t)row * 1024 + (pn - 10) * 256 + cl) = v;
                        else if (pn < 22) *(f32x4*)(XBC + (size_t)row * 2048 + (pn - 14) * 256 + cl) = v;
                        else { if (cl < 48) { f32x4 s; s.x = sigmoidf_(v.x); s.y = sigmoidf_(v.y); s.z = sigmoidf_(v.z); s.w = sigmoidf_(v.w); *(f32x4*)(GATE + (size_t)row * 48 + cl) = s; }
                               else if (cl < 64) *(f32x4*)(DTR + (size_t)row * 16 + (cl - 48)) = v; }
                    }
            }
    }
};
struct EpiF32 {
    static constexpr bool PERM = false, AFTER_DRAIN = false;
    float* O; int ldc;
    __device__ __forceinline__ void operator()(const pg8::f32x4 (&acc)[2][2][4][2], const pg8::Unit& u, int wr, int wc, int fr, int fq) const {
#pragma unroll
        for (int ai = 0; ai < 2; ++ai)
#pragma unroll
            for (int m = 0; m < 4; ++m) { float* rowp = O + (size_t)(u.pm * 256 + ai * 128 + wr * 64 + m * 16 + fr) * ldc + u.pn * 256 + wc * 32 + fq * 4;
#pragma unroll
                for (int bj = 0; bj < 2; ++bj)
#pragma unroll
                    for (int n = 0; n < 2; ++n) *(f32x4*)(rowp + bj * 128 + n * 16) = acc[ai][bj][m][n]; }
    }
};
struct EpiBf16P {
    static constexpr bool PERM = true, AFTER_DRAIN = false;
    bf16* O; int ldc;
    __device__ __forceinline__ void operator()(const pg8::f32x4 (&acc)[2][2][4][2], const pg8::Unit& u, int wr, int wc, int fr, int fq) const {
#pragma unroll
        for (int ai = 0; ai < 2; ++ai)
#pragma unroll
            for (int m = 0; m < 4; ++m) { bf16* rowp = O + (size_t)(u.pm * 256 + ai * 128 + wr * 64 + m * 16 + fr) * ldc + u.pn * 256 + wc * 32 + fq * 8;
#pragma unroll
                for (int bj = 0; bj < 2; ++bj) { const f32x4 v0 = acc[ai][bj][m][0], v1 = acc[ai][bj][m][1]; u32x4 w; w.x = pk2(v0.x, v0.y); w.y = pk2(v0.z, v0.w); w.z = pk2(v1.x, v1.y); w.w = pk2(v1.z, v1.w); *(u32x4*)(rowp + bj * 128) = w; } }
    }
};
struct EpiGate {
    static constexpr bool PERM = true, AFTER_DRAIN = false;
    bf16* GP; float* out; bf16* UP;
    __device__ __forceinline__ void operator()(const pg8::f32x4 (&acc)[2][2][4][2], const pg8::Unit& u, int wr, int wc, int fr, int fq) const {
        const bool isup = u.pn >= 22; bf16* const dstm = isup ? UP : GP; const int colt = (isup ? u.pn - 22 : u.pn) * 256 + wc * 32 + 8 * fq;
#pragma unroll
        for (int ai = 0; ai < 2; ++ai)
#pragma unroll
            for (int m = 0; m < 4; ++m) { const int row = u.pm * 256 + ai * 128 + wr * 64 + m * 16 + fr;
                const bool isp = row < MP; const int b = isp ? (row >> 11) : ((row - MP) >> 3); const int t = isp ? (row & 2047) : ((row - MP) & 7);
                const int tl = isp ? t - (TP - 2) : t - (TS - 2);
#pragma unroll
                for (int bj = 0; bj < 2; ++bj) { const int col = colt + bj * 128; const f32x4 v0 = acc[ai][bj][m][0], v1 = acc[ai][bj][m][1];
                    u32x4 w; w.x = pk2(v0.x, v0.y); w.y = pk2(v0.z, v0.w); w.z = pk2(v1.x, v1.y); w.w = pk2(v1.z, v1.w); *(u32x4*)(dstm + (size_t)row * DFFP + col) = w;
                    if (!isup && tl >= 0 && col < DFF) { float* dst = (isp ? out + O_FCP : out + O_FCS) + ((size_t)b * 2 + tl) * DFF + col; *(f32x4*)dst = v0; *(f32x4*)(dst + 4) = v1; } } }
    }
};
struct EpiBf {
    static constexpr bool PERM = false, AFTER_DRAIN = false;
    bf16* O; int ldc;
    __device__ __forceinline__ void operator()(const pg8::f32x4 (&acc)[2][2][4][2], const pg8::Unit& u, int wr, int wc, int fr, int fq) const {
#pragma unroll
        for (int ai = 0; ai < 2; ++ai)
#pragma unroll
            for (int m = 0; m < 4; ++m) { bf16* rowp = O + (size_t)(u.pm * 256 + ai * 128 + wr * 64 + m * 16 + fr) * ldc + u.pn * 256 + wc * 32 + fq * 4;
#pragma unroll
                for (int bj = 0; bj < 2; ++bj)
#pragma unroll
                    for (int n = 0; n < 2; ++n) { const f32x4 v = acc[ai][bj][m][n]; u32x2 w; w.x = pk2(v.x, v.y); w.y = pk2(v.z, v.w); *(u32x2*)(rowp + bj * 128 + n * 16) = w; } }
    }
};
DI void bf8_to_f(const u32x4 p, float (&f)[8]) { f[0] = __uint_as_float(p.x << 16); f[1] = __uint_as_float(p.x & 0xffff0000u); f[2] = __uint_as_float(p.y << 16); f[3] = __uint_as_float(p.y & 0xffff0000u);
    f[4] = __uint_as_float(p.z << 16); f[5] = __uint_as_float(p.z & 0xffff0000u); f[6] = __uint_as_float(p.w << 16); f[7] = __uint_as_float(p.w & 0xffff0000u); }
DI void act_pass(Frame& F, int R) {
    const bf16* GP = wsp<bf16>(F, WS_GP); const bf16* UP = wsp<bf16>(F, WS_UP); bf16* ACT = wsp<bf16>(F, WS_ACT);
    const float* dww = inp(F, I_DWW); const float* dwb = inp(F, I_DWB); const float* hist = inp(F, I_FCONV);
    const int gt = F.vcu * NTHR + F.tid, NGT = F.G * NTHR; constexpr int NR = 4, NCG = DFFP / 8, NITEM = (MT / NR) * NCG;
    for (int ii = gt; ii < NITEM * R; ii += NGT) { const int it = ii % NITEM; const int rq = it / NCG, cg = it % NCG, c0 = cg * 8, row0 = rq * NR;
        if (c0 >= DFF) {
#pragma unroll
            for (int k = 0; k < NR; ++k) *(u32x4*)(ACT + (size_t)(row0 + k) * DFFP + c0) = (u32x4){0u, 0u, 0u, 0u};
            continue; }
        const bool isp = row0 < MP; const int b = isp ? (row0 >> 11) : ((row0 - MP) >> 3); const int t0 = isp ? (row0 & 2047) : ((row0 - MP) & 7);
        float g[NR + 2][8];
#pragma unroll
        for (int k = 0; k < NR + 2; ++k) { const int tt = t0 - 2 + k;
            if (tt >= 0) bf8_to_f(*(const u32x4*)(GP + (size_t)(row0 - 2 + k) * DFFP + c0), g[k]);
            else if (isp) {
#pragma unroll
                for (int e = 0; e < 8; ++e) g[k][e] = 0.f; }
            else { const f32x4 h0 = *(const f32x4*)(hist + ((size_t)b * 2 + (2 + tt)) * DFF + c0), h1 = *(const f32x4*)(hist + ((size_t)b * 2 + (2 + tt)) * DFF + c0 + 4);
                g[k][0] = h0.x; g[k][1] = h0.y; g[k][2] = h0.z; g[k][3] = h0.w; g[k][4] = h1.x; g[k][5] = h1.y; g[k][6] = h1.z; g[k][7] = h1.w; } }
        float w0[8], w1[8], w2[8], bb[8];
#pragma unroll
        for (int e = 0; e < 8; e += 4) { const f32x4 a = *(const f32x4*)(dww + c0 + e), bq = *(const f32x4*)(dww + DFF + c0 + e), cq = *(const f32x4*)(dww + 2 * DFF + c0 + e), dq = *(const f32x4*)(dwb + c0 + e);
            w0[e] = a.x; w0[e + 1] = a.y; w0[e + 2] = a.z; w0[e + 3] = a.w; w1[e] = bq.x; w1[e + 1] = bq.y; w1[e + 2] = bq.z; w1[e + 3] = bq.w;
            w2[e] = cq.x; w2[e + 1] = cq.y; w2[e + 2] = cq.z; w2[e + 3] = cq.w; bb[e] = dq.x; bb[e + 1] = dq.y; bb[e + 2] = dq.z; bb[e + 3] = dq.w; }
#pragma unroll
        for (int k = 0; k < NR; ++k) { float up[8]; bf8_to_f(*(const u32x4*)(UP + (size_t)(row0 + k) * DFFP + c0), up); float a[8];
#pragma unroll
            for (int e = 0; e < 8; ++e) a[e] = gelu_tanh(bb[e] + w0[e] * g[k][e] + w1[e] * g[k + 1][e] + w2[e] * g[k + 2][e]) * up[e];
            u32x4 o; o.x = pk2(a[0], a[1]); o.y = pk2(a[2], a[3]); o.z = pk2(a[4], a[5]); o.w = pk2(a[6], a[7]); *(u32x4*)(ACT + (size_t)(row0 + k) * DFFP + c0) = o; }
    }
}

DI void compress_half(Frame& F, int it) {
    const int kv = it & 1, blk = (it >> 1) & 3, bb = it >> 3;
    const bool isp = bb < 4; const int b = isp ? bb : bb - 4;
    const int lane = F.lane, r = lane & 31, h = lane >> 5, w = F.wave, q = w & 3, half = w >> 2, tid = F.tid;
    const bf16* W12T = wsp<bf16>(F, WS_W12) + (size_t)kv * 256 * 1024;
    LAS unsigned char* AL = F.lds;
    LAS float* X = (LAS float*)F.lds;
    LAS bf16* G = (LAS bf16*)(F.lds + 65536);
    LAS int* ptl = (LAS int*)(F.lds + 130944);
    constexpr int ABUF = 132 * 272;
    __syncthreads();
    if (tid < 16) ptl[tid] = isp ? 0 : F.pt[b * 16 + tid];
    __syncthreads();
    const float* src = (isp ? F.out + O_KVP + (size_t)b * 2048 * 1024 : inp(F, I_CKV)) + kv * 256 + (tid & 63) * 4;
    const int rr = (tid >> 6) & 1;
    const bool x9 = tid < 128;
    unsigned ro[9];
#pragma unroll
    for (int k = 0; k < 9; ++k) { const int c = (k < 8) ? (tid >> 7) + 4 * k : 32; int cg = 32 * blk + c; if (cg > 127) cg = 127;
        const unsigned rowi = isp ? (unsigned)(16 * cg) : (unsigned)ptl[cg >> 3] * 128u + (unsigned)((cg & 7) * 16); ro[k] = (rowi + rr) * 1024u; }
    f32x4 ra[9];
    const int s0 = (int)((blockIdx.x ^ (blockIdx.x >> 3)) & 7);
#define CMP_SIG(s_) ((unsigned)(((s_) + s0) & 7))
#define CMP_LOADA(s_) do { _Pragma("unroll") for (int k = 0; k < 8; ++k) ra[k] = *(const f32x4*)(src + (size_t)(ro[k] + CMP_SIG(s_) * 2048u)); \
        if (x9) { if (blk < 3) ra[8] = *(const f32x4*)(src + (size_t)(ro[8] + CMP_SIG(s_) * 2048u)); else ra[8] = (f32x4){0.f, 0.f, 0.f, 0.f}; } } while (0)
#define CMP_STOREA(buf) do { LAS unsigned char* dst_ = AL + (buf) * ABUF + (((tid & 63) >> 4) * 33 + (tid >> 7)) * 272 + (rr * 64 + (tid & 15) * 4) * 2; \
        _Pragma("unroll") for (int k = 0; k < 8; ++k) { u32x2 p; p.x = pk2(ra[k].x, ra[k].y); p.y = pk2(ra[k].z, ra[k].w); *(LAS u32x2*)(dst_ + 4 * k * 272) = p; } \
        if (x9) { u32x2 p; p.x = pk2(ra[8].x, ra[8].y); p.y = pk2(ra[8].z, ra[8].w); *(LAS u32x2*)(dst_ + 32 * 272) = p; } } while (0)
    const bf16* bp = W12T + ((size_t)(half * 4 + q) * 4096 + lane) * 8;
    bf16x8 wa[8];
#define CMP_LOADW(W, s_) do { _Pragma("unroll") for (int t = 0; t < 8; ++t) W[t] = *(const bf16x8*)(bp + (8 * CMP_SIG(s_) + t) * 512); } while (0)
    f32x16 acc[4];
#pragma unroll
    for (int g = 0; g < 4; ++g) acc[g] = (f32x16){};
    CMP_LOADA(0); CMP_LOADW(wa, 0); CMP_STOREA(0);
    __syncthreads();
#define CMP_SLICE(s_, bufc) do { if ((s_) + 1 < 8) CMP_LOADA((s_) + 1); \
        __builtin_amdgcn_sched_barrier(0);                 \
        { const LAS unsigned char* Ab = AL + (bufc) * ABUF + (r + half) * 272 + 16 * h; \
          _Pragma("unroll") for (int tt = 0; tt < 8; ++tt) { _Pragma("unroll") for (int g = 0; g < 4; ++g) { const bf16x8 af = *(const LAS bf16x8*)(Ab + g * 33 * 272 + 32 * tt); acc[g] = MFMA32(af, wa[tt], acc[g]); } \
              if ((s_) + 1 < 8) wa[tt] = *(const bf16x8*)(bp + (8 * CMP_SIG((s_) + 1) + tt) * 512); } } \
        if ((s_) + 1 < 8) CMP_STOREA(1 - (bufc)); \
        __syncthreads(); } while (0)
#pragma unroll 1
    for (int s2 = 0; s2 < 8; s2 += 2) { CMP_SLICE(s2, 0); CMP_SLICE(s2 + 1, 1); }
#undef CMP_SLICE
#undef CMP_SIG
#undef CMP_LOADW
#undef CMP_LOADA
#undef CMP_STOREA
    int xb = 32 * q + r; asm volatile("" : "+v"(xb));
    if (half) {
#pragma unroll
        for (int g = 0; g < 4; ++g)
#pragma unroll
            for (int reg = 0; reg < 16; ++reg) X[(32 * g + crow(reg, h)) * 128 + xb] = acc[g][reg]; }
    __syncthreads();
    if (!half) {
        float cb = inp(F, I_CB1)[kv * 128 + 32 * q + r];
        { const float* CBP = wsp<float>(F, WS_CBP) + kv * 8 * 128 + 32 * q + r;
#pragma unroll
          for (int p = 0; p < 8; ++p) cb += CBP[p * 128]; }
#pragma unroll
        for (int g = 0; g < 4; ++g)
#pragma unroll
            for (int reg = 0; reg < 16; ++reg) { const int n = 32 * g + crow(reg, h);
                G[n * 136 + xb] = (bf16)(pk2(gelu_tanh(acc[g][reg] + X[n * 128 + xb] + cb), 0.f) & 0xffffu); } }
    __syncthreads();
    { const int g2 = q, dg = half; const bf16* W2T = wsp<bf16>(F, WS_W2T) + (size_t)kv * 64 * 128; const int unit = (isp ? 0 : 16) + b * 4 + g2;
      f32x16 o0 = (f32x16){};
#pragma unroll
      for (int ks = 0; ks < 8; ++ks) { const bf16x8 af = *(const LAS bf16x8*)(G + (32 * g2 + r) * 136 + 16 * ks + 8 * h);
          const bf16x8 w0 = *(const bf16x8*)(W2T + (size_t)(32 * dg + r) * 128 + 16 * ks + 8 * h); o0 = MFMA32(af, w0, o0); }
      const float bb0 = inp(F, I_CB2)[kv * 64 + 32 * dg + r];
      if (kv == 0) { bf16* KCK = wsp<bf16>(F, WS_KCK) + (size_t)unit * 8192;
#pragma unroll
          for (int reg = 0; reg < 16; ++reg) { const int n = 32 * blk + crow(reg, h); KCK[n * 64 + 32 * dg + r] = (bf16)(pk2(o0[reg] + bb0, 0.f) & 0xffffu); } }
      else { bf16* KCVT = wsp<bf16>(F, WS_KCVT) + (size_t)unit * 8192;
#pragma unroll
          for (int a = 0; a < 4; ++a) { const int n = 32 * blk + 8 * a + 4 * h;
              u32x2 x0; x0.x = pk2(o0[4 * a] + bb0, o0[4 * a + 1] + bb0); x0.y = pk2(o0[4 * a + 2] + bb0, o0[4 * a + 3] + bb0); *(u32x2*)(KCVT + (size_t)(32 * dg + r) * 128 + n) = x0; } }
    }
}

DI void ssm_pre(Frame& F, int rank, int nranks) {
    const float* XBC = wsp<float>(F, WS_XBC); float* XBCC = wsp<float>(F, WS_XBCC); const float* DTR = wsp<float>(F, WS_DTR); float* DT = wsp<float>(F, WS_DT);
    const float* cw = inp(F, I_SCW); const float* cbias = inp(F, I_SCB); const float* hist = inp(F, I_SCONV);
    const int gt = rank * NTHR + F.tid, NGT = nranks * NTHR;
    for (int i = gt; i < MT * 512; i += NGT) { const int row = i >> 9, c = (i & 511) * 4;
        const bool isp = row < MP; const int b = isp ? (row >> 11) : ((row - MP) >> 3); const int t = isp ? (row & 2047) : ((row - MP) & 7);
        f32x4 acc = *(const f32x4*)(cbias + c);
#pragma unroll
        for (int k = 0; k < 4; ++k) { const int tt = t - 3 + k; f32x4 xv;
            if (tt >= 0) xv = *(const f32x4*)(XBC + (size_t)(row - 3 + k) * 2048 + c);
            else if (isp) xv = (f32x4){0.f, 0.f, 0.f, 0.f};
            else xv = *(const f32x4*)(hist + ((size_t)b * 3 + (3 + tt)) * 2048 + c);
            acc += *(const f32x4*)(cw + k * 2048 + c) * xv; }
        f32x4 o; o.x = siluf_(acc.x); o.y = siluf_(acc.y); o.z = siluf_(acc.z); o.w = siluf_(acc.w);
        *(f32x4*)(XBCC + (size_t)row * 2048 + c) = o;
        if (isp) { if (t >= TP - 3) *(f32x4*)(F.out + O_SCP + ((size_t)b * 3 + (t - (TP - 3))) * 2048 + c) = *(const f32x4*)(XBC + (size_t)row * 2048 + c); }
        else { if (t >= TS - 3) *(f32x4*)(F.out + O_SCS + ((size_t)b * 3 + (t - (TS - 3))) * 2048 + c) = *(const f32x4*)(XBC + (size_t)row * 2048 + c); }
    }
    for (int i = gt; i < MT * 16; i += NGT) DT[i] = softplusf_(DTR[i] + inp(F, I_DTB)[i & 15]);
}

struct AState { float m, l; f32x16 o0, o1; };
DI void astate_init(AState& s) { s.m = NEGF; s.l = 0.f; s.o0 = (f32x16){}; s.o1 = (f32x16){}; }
DI bf16x8 pack8(const f32x16& x, int s) {
    u32x4 p; p.x = pk2(x[8 * s], x[8 * s + 1]); p.y = pk2(x[8 * s + 2], x[8 * s + 3]); p.z = pk2(x[8 * s + 4], x[8 * s + 5]); p.w = pk2(x[8 * s + 6], x[8 * s + 7]); return __builtin_bit_cast(bf16x8, p);
}
constexpr float LOG2E = 1.4426950408889634f, SCL2 = 0.125f * 1.4426950408889634f;
struct MaskBias {
    int t;
    unsigned long long mask;
    bool use_mask;
    int kbase;
    int maxdist;
    int klimit;
    int hd;
    const LAS float* lut;
    DI float score(float raw, int tile, int kk, bool selbit) const {
        const int kidx = tile * 64 + kk, dist = t - (kbase + kidx);
        const bool valid = dist >= 0 && dist <= maxdist && kidx < klimit && selbit;
        const int dc = dist < 0 ? 0 : (dist > 127 ? 127 : dist);
        return valid ? raw * SCL2 + lut[dc * 16 + hd] : NEGF;
    }
    DI bool selbit(int tile) const { return use_mask ? (((mask >> tile) & 1ull) != 0ull) : true; }
};
struct TileBf { bf16x8 k[2][4]; s16x4 vlo[2][2][2], vhi[2][2][2]; };
struct KVbf {
    const bf16* K; const bf16* VT; int vpitch;
    typedef TileBf Tile;
    DI void load(TileBf& t, int tile, int r, int h) const {
#pragma unroll
        for (int kh = 0; kh < 2; ++kh)
#pragma unroll
            for (int step = 0; step < 4; ++step) t.k[kh][step] = *(const bf16x8*)(K + (size_t)(tile * 64 + kh * 32 + r) * 64 + step * 16 + h * 8);
#pragma unroll
        for (int kh = 0; kh < 2; ++kh)
#pragma unroll
            for (int s = 0; s < 2; ++s)
#pragma unroll
                for (int dg = 0; dg < 2; ++dg) { const bf16* p = VT + (size_t)(dg * 32 + r) * vpitch + tile * 64 + kh * 32 + s * 16 + h * 4; t.vlo[kh][s][dg] = *(const s16x4*)p; t.vhi[kh][s][dg] = *(const s16x4*)(p + 8); }
    }
    DI void load2(TileBf&, int, int, int) const {}
    static DI bf16x8 kf(const TileBf& t, int kh, int step) { return t.k[kh][step]; }
    static DI bf16x8 vf(const TileBf& t, int kh, int s, int dg) { return __builtin_shufflevector(t.vlo[kh][s][dg], t.vhi[kh][s][dg], 0, 1, 2, 3, 4, 5, 6, 7); }
    DI bf16x8 kfrag(int tile, int kh, int step, int r, int h) const { return *(const bf16x8*)(K + (size_t)(tile * 64 + kh * 32 + r) * 64 + step * 16 + h * 8); }
    DI bf16x8 vfrag(int tile, int kh, int s, int dg, int r, int h) const { const bf16* p = VT + (size_t)(dg * 32 + r) * vpitch + tile * 64 + kh * 32 + s * 16 + h * 4;
        const s16x4 lo = *(const s16x4*)p, hi = *(const s16x4*)(p + 8); return __builtin_shufflevector(lo, hi, 0, 1, 2, 3, 4, 5, 6, 7); }
};
struct KVf32 { __amdgpu_buffer_rsrc_t rs; int stride_b, koff_b, voff_b; };
DI void attn_half_f32(AState& st, const bf16x8 (&qf)[4], const KVf32& kv, int tile, int kh, const MaskBias& mb, int r, int h) {
    u32x4 kq[4][2]; unsigned vq[2][2][8];
    const int vk = r * kv.stride_b + h * 32, vv = 4 * h * kv.stride_b + r * 4;
#pragma unroll
    for (int step = 0; step < 4; ++step) { const int so = kh * 32 * kv.stride_b + kv.koff_b + step * 64;
        kq[step][0] = __builtin_amdgcn_raw_buffer_load_b128(kv.rs, vk, so, 0); kq[step][1] = __builtin_amdgcn_raw_buffer_load_b128(kv.rs, vk, so + 16, 0); }
#pragma unroll
    for (int s = 0; s < 2; ++s)
#pragma unroll
        for (int j = 0; j < 8; ++j) { const int so = (kh * 32 + 16 * s + 8 * (j >> 2) + (j & 3)) * kv.stride_b + kv.voff_b;
            vq[s][0][j] = __builtin_amdgcn_raw_buffer_load_b32(kv.rs, vv, so, 0); vq[s][1][j] = __builtin_amdgcn_raw_buffer_load_b32(kv.rs, vv, so + 128, 0); }
    f32x16 s0 = (f32x16){};
#pragma unroll
    for (int step = 0; step < 4; ++step) s0 = MFMA32(cvt8(__builtin_bit_cast(f32x4, kq[step][0]), __builtin_bit_cast(f32x4, kq[step][1])), qf[step], s0);
    float tmax = NEGF;
    const bool sb = mb.selbit(tile);
#pragma unroll
    for (int reg = 0; reg < 16; ++reg) { s0[reg] = mb.score(s0[reg], tile, kh * 32 + crow(reg, h), sb); tmax = fmaxf(tmax, s0[reg]); }
    tmax = fmaxf(tmax, __shfl_xor(tmax, 32));
    const bool grow = __any(tmax > st.m + 8.0f);
    const float mnew = grow ? fmaxf(st.m, tmax) : st.m, alpha = grow ? __builtin_amdgcn_exp2f(st.m - mnew) : 1.0f;
    float ls = 0.f;
    const float msub = fmaxf(mnew, -1e29f);
#pragma unroll
    for (int reg = 0; reg < 16; ++reg) { const float p0 = __builtin_amdgcn_exp2f(s0[reg] - msub); s0[reg] = p0; ls += p0; }
    ls += __shfl_xor(ls, 32);
    st.l = st.l * alpha + ls; st.m = mnew;
    if (grow && __any(alpha != 1.0f)) {
#pragma unroll
        for (int reg = 0; reg < 16; ++reg) { const float a = __shfl(alpha, crow(reg, h)); st.o0[reg] *= a; st.o1[reg] *= a; }
    }
#pragma unroll
    for (int s = 0; s < 2; ++s) { const bf16x8 pf = pack8(s0, s);
#pragma unroll
        for (int dg = 0; dg < 2; ++dg) { const unsigned* v = vq[s][dg]; u32x4 p;
            p.x = pk2(__uint_as_float(v[0]), __uint_as_float(v[1])); p.y = pk2(__uint_as_float(v[2]), __uint_as_float(v[3])); p.z = pk2(__uint_as_float(v[4]), __uint_as_float(v[5])); p.w = pk2(__uint_as_float(v[6]), __uint_as_float(v[7]));
            const bf16x8 vf = __builtin_bit_cast(bf16x8, p); if (dg == 0) st.o0 = MFMA32(pf, vf, st.o0); else st.o1 = MFMA32(pf, vf, st.o1); } }
}
template <class KV> DI void attn_tile(AState& st, const bf16x8 (&qf)[4], const KV& kv, int tile, const MaskBias& mb, int r, int h, bool far = false) {
    typename KV::Tile tl; kv.load(tl, tile, r, h);
    f32x16 s0 = (f32x16){}, s1 = (f32x16){};
#pragma unroll
    for (int step = 0; step < 4; ++step) { s0 = MFMA32(KV::kf(tl, 0, step), qf[step], s0); s1 = MFMA32(KV::kf(tl, 1, step), qf[step], s1); }
    kv.load2(tl, tile, r, h);
    float tmax = NEGF; const bool sb = mb.selbit(tile);
    if (far) { const float cf = mb.lut[127 * 16 + mb.hd];
#pragma unroll
        for (int reg = 0; reg < 16; ++reg) { s0[reg] = sb ? s0[reg] * SCL2 + cf : NEGF; s1[reg] = sb ? s1[reg] * SCL2 + cf : NEGF; tmax = fmaxf(tmax, fmaxf(s0[reg], s1[reg])); } }
    else {
#pragma unroll
        for (int reg = 0; reg < 16; ++reg) { const int kk = crow(reg, h); s0[reg] = mb.score(s0[reg], tile, kk, sb); s1[reg] = mb.score(s1[reg], tile, 32 + kk, sb); tmax = fmaxf(tmax, fmaxf(s0[reg], s1[reg])); } }
    tmax = fmaxf(tmax, __shfl_xor(tmax, 32));
    const bool grow = __any(tmax > st.m + 8.0f);
    const float mnew = grow ? fmaxf(st.m, tmax) : st.m, alpha = grow ? __builtin_amdgcn_exp2f(st.m - mnew) : 1.0f;
    float ls = 0.f;
    const float msub = fmaxf(mnew, -1e29f);
#pragma unroll
    for (int reg = 0; reg < 16; ++reg) { const float p0 = __builtin_amdgcn_exp2f(s0[reg] - msub), p1 = __builtin_amdgcn_exp2f(s1[reg] - msub); s0[reg] = p0; s1[reg] = p1; ls += p0 + p1; }
    ls += __shfl_xor(ls, 32);
    st.l = st.l * alpha + ls; st.m = mnew;
    if (grow && __any(alpha != 1.0f)) {
#pragma unroll
        for (int reg = 0; reg < 16; ++reg) { const float a = __shfl(alpha, crow(reg, h)); st.o0[reg] *= a; st.o1[reg] *= a; }
    }
#pragma unroll
    for (int s = 0; s < 2; ++s) { const bf16x8 pf = pack8(s0, s); st.o0 = MFMA32(pf, KV::vf(tl, 0, s, 0), st.o0); st.o1 = MFMA32(pf, KV::vf(tl, 0, s, 1), st.o1); }
#pragma unroll
    for (int s = 0; s < 2; ++s) { const bf16x8 pf = pack8(s1, s); st.o0 = MFMA32(pf, KV::vf(tl, 1, s, 0), st.o0); st.o1 = MFMA32(pf, KV::vf(tl, 1, s, 1), st.o1); }
}
template <int CTRL> DI float qperm(float x) { return __int_as_float(__builtin_amdgcn_mov_dpp(__float_as_int(x), CTRL, 0xf, 0xf, true)); }
DI unsigned long long cmp_branch(const bf16x8 (&qf)[4], const bf16* KCK, const bf16* KCVT, int tq, int hd, const LAS float* lut, int ns, volatile LAS float* scr, f32x16& oc0, f32x16& oc1, int lane) {
    const int r = lane & 31, h = lane >> 5, qi = r >> 2;
    KVbf kv{KCK, KCVT, 128};
    f32x16 S[4];
#pragma unroll
    for (int T = 0; T < 4; ++T) { S[T] = (f32x16){};
#pragma unroll
        for (int step = 0; step < 4; ++step) S[T] = MFMA32(kv.kfrag(T >> 1, T & 1, step, r, h), qf[step], S[T]); }
    asm volatile("" ::: "memory");
    float mx = NEGF;
#pragma unroll
    for (int T = 0; T < 4; ++T)
#pragma unroll
        for (int reg = 0; reg < 16; ++reg) { const int n = 32 * T + crow(reg, h), dist = tq - (16 * n + 31); const int dc = dist < 0 ? 0 : (dist > 127 ? 127 : dist);
            const float s = dist >= 0 ? S[T][reg] * SCL2 + lut[dc * 16 + hd] : NEGF; S[T][reg] = s; mx = fmaxf(mx, s); }
    mx = fmaxf(mx, __shfl_xor(mx, 32));
    float l = 0.f;
#pragma unroll
    for (int T = 0; T < 4; ++T)
#pragma unroll
        for (int reg = 0; reg < 16; ++reg) { const float p = S[T][reg] > -1e29f ? __builtin_amdgcn_exp2f(S[T][reg] - mx) : 0.f; S[T][reg] = p; l += p; }
    l += __shfl_xor(l, 32);
    const float inv = 1.0f / fmaxf(l, TINYF);
#pragma unroll
    for (int T = 0; T < 4; ++T) S[T] *= inv;
    volatile LAS float* impA = scr; volatile LAS float* impB = scr + 8 * 34;
#pragma unroll
    for (int T = 0; T < 4; ++T)
#pragma unroll
        for (int a = 0; a < 4; ++a) { float e = S[T][4 * a] + S[T][4 * a + 1] + S[T][4 * a + 2] + 0.5f * S[T][4 * a + 3], c = 0.5f * S[T][4 * a + 3];
            e += qperm<0xB1>(e); e += qperm<0x4E>(e); c += qperm<0xB1>(c); c += qperm<0x4E>(c);
            if ((r & 3) == 0) { const int s = 8 * T + 2 * a + h; impA[qi * 34 + s] = e; impB[qi * 34 + s + 1] = c; } }
    if (lane < 8) { impB[lane * 34] = 0.f; impA[lane * 34 + 32] = 0.f; }
    LDS_WAIT();
    volatile LAS float* vv = scr + 8 * 34 * 2 + 16;
#pragma unroll 1
    for (int pp = 0; pp < 4; ++pp) { const int qa = 2 * pp + h, s = r; const int tqa = __shfl(tq, qa * 4), qb = tqa >> 6;
        float my = impA[qa * 34 + s] + impB[qa * 34 + s]; if (s == 0 || s == qb || s == qb - 1) my += 1.0e4f;
        vv[qa * 32 + s] = (s <= qb) ? my : -3.0e38f; }
    LDS_WAIT();
#pragma unroll 1
    for (int pp = 0; pp < 4; ++pp) { const int qa = 2 * pp + h, s = r; const int tqa = __shfl(tq, qa * 4), qb = tqa >> 6;
        const float my = vv[qa * 32 + s]; int rank = 0;
#pragma unroll 8
        for (int s2 = 0; s2 < 32; ++s2) { const float v2 = vv[qa * 32 + s2]; rank += (v2 > my || (v2 == my && s2 < s)) ? 1 : 0; }
        const bool extra = (ns == 33) && (qb == 32);
        const bool selq = (s <= qb) && (rank < (extra ? 7 : 8));
        const unsigned long long bal = __ballot(selq);
        if (s == 0) { scr[8 * 34 * 2 + 2 * qa] = __uint_as_float(h ? (unsigned)(bal >> 32) : (unsigned)bal); scr[8 * 34 * 2 + 2 * qa + 1] = __uint_as_float(extra ? 1u : 0u); } }
    LDS_WAIT();
    const unsigned long long mask = (unsigned long long)__float_as_uint(scr[8 * 34 * 2 + 2 * qi]) | ((unsigned long long)__float_as_uint(scr[8 * 34 * 2 + 2 * qi + 1]) << 32);
    oc0 = (f32x16){}; oc1 = (f32x16){};
#pragma unroll
    for (int T = 0; T < 4; ++T)
#pragma unroll
        for (int s = 0; s < 2; ++s) { asm volatile("" ::: "memory"); const bf16x8 pf = pack8(S[T], s); oc0 = MFMA32(pf, kv.vfrag(T >> 1, T & 1, s, 0, r, h), oc0); oc1 = MFMA32(pf, kv.vfrag(T >> 1, T & 1, s, 1, r, h), oc1); }
    return mask;
}
DI void attn_prompt_unit(Frame& F, int wu, volatile LAS float* scr, volatile LAS float* ost) {
    const int lane = F.lane, r = lane & 31, h = lane >> 5, qi = r >> 2, rh = r & 3;
    const int bg = wu >> 8, qo = wu & 255, b = bg >> 2, g = bg & 3, t = 8 * qo + qi, row = b * 2048 + t, hd = g * 4 + rh;
    const LAS float* lut = (const LAS float*)(F.lds + LUT_OFF);
    const bf16* QB = wsp<bf16>(F, WS_QB);
    bf16x8 qf[4];
#pragma unroll
    for (int step = 0; step < 4; ++step) qf[step] = *(const bf16x8*)(QB + (size_t)row * 1024 + hd * 64 + step * 16 + h * 8);
    f32x16 oc0, oc1;
    if ((DBL >> 21) & 1) { const unsigned long long m0 = cmp_branch(qf, wsp<bf16>(F, WS_KCK) + (size_t)bg * 8192, wsp<bf16>(F, WS_KCVT) + (size_t)bg * 8192, t, hd, lut, 32, scr, oc0, oc1, lane); asm volatile("" :: "v"((unsigned)m0), "v"(oc0[0]), "v"(oc1[5])); }
    const unsigned long long mask = cmp_branch(qf, wsp<bf16>(F, WS_KCK) + (size_t)bg * 8192, wsp<bf16>(F, WS_KCVT) + (size_t)bg * 8192, t, hd, lut, 32, scr, oc0, oc1, lane);
    unsigned long long om = mask;
#pragma unroll
    for (int o = 4; o < 32; o <<= 1) om |= __shfl_xor(om, o);
    om = __shfl(om, 0);
    const int qb = qo >> 3;
    const float* GATE = wsp<float>(F, WS_GATE) + (size_t)row * 48;
    { const float f0 = GATE[hd];
#pragma unroll
      for (int reg = 0; reg < 16; ++reg) { const float a0 = __shfl(f0, crow(reg, h)); ost[(reg * 2) * 64 + lane] = a0 * oc0[reg]; ost[(reg * 2 + 1) * 64 + lane] = a0 * oc1[reg]; } }
    { AState ss; astate_init(ss);
      KVbf kv{wsp<bf16>(F, WS_KB) + (size_t)((b * 2 + 0) * 4 + g) * 2048 * 64, wsp<bf16>(F, WS_VT) + (size_t)((b * 2 + 0) * 4 + g) * 64 * 2048, 2048};
      MaskBias mb{t, mask, true, 0, 1 << 30, 1 << 30, hd, lut};
      if ((DBL >> 22) & 1) { AState d2; astate_init(d2); for (int j = 0; j <= qb; ++j) { if (!((om >> j) & 1ull)) continue; attn_tile(d2, qf, kv, j, mb, r, h, 64 * j <= 8 * qo - 176); } asm volatile("" :: "v"(d2.l), "v"(d2.o0[0]), "v"(d2.o1[7])); }
#pragma unroll 1
      for (int j = 0; j <= qb; ++j) { if (!((om >> j) & 1ull)) continue; attn_tile(ss, qf, kv, j, mb, r, h, 64 * j <= 8 * qo - 176); }
      const float f1 = GATE[16 + hd] / fmaxf(ss.l, TINYF);
#pragma unroll
      for (int reg = 0; reg < 16; ++reg) { const float a1 = __shfl(f1, crow(reg, h)); ost[(reg * 2) * 64 + lane] += a1 * ss.o0[reg]; ost[(reg * 2 + 1) * 64 + lane] += a1 * ss.o1[reg]; } }
    { AState sw; astate_init(sw);
      KVbf kv{wsp<bf16>(F, WS_KB) + (size_t)((b * 2 + 1) * 4 + g) * 2048 * 64, wsp<bf16>(F, WS_VT) + (size_t)((b * 2 + 1) * 4 + g) * 64 * 2048, 2048};
      MaskBias mb{t, 0ull, false, 0, 512, 1 << 30, hd, lut};
      const int j0 = (8 * qo - 512) < 0 ? 0 : ((8 * qo - 512) >> 6);
      if ((DBL >> 23) & 1) { AState d2; astate_init(d2); for (int j = j0; j <= qb; ++j) attn_tile(d2, qf, kv, j, mb, r, h, (64 * j <= 8 * qo - 176) && (64 * j >= 8 * qo - 505)); asm volatile("" :: "v"(d2.l), "v"(d2.o0[0]), "v"(d2.o1[7])); }
#pragma unroll 1
      for (int j = j0; j <= qb; ++j) attn_tile(sw, qf, kv, j, mb, r, h, (64 * j <= 8 * qo - 176) && (64 * j >= 8 * qo - 505));
      const float f2 = GATE[32 + hd] / fmaxf(sw.l, TINYF);
      bf16* MIX = wsp<bf16>(F, WS_MIX);
#pragma unroll
      for (int reg = 0; reg < 16; ++reg) { const int qr = crow(reg, h); const float a2 = __shfl(f2, qr);
          const float v0 = ost[(reg * 2) * 64 + lane] + a2 * sw.o0[reg], v1 = ost[(reg * 2 + 1) * 64 + lane] + a2 * sw.o1[reg];
          bf16* op = MIX + (size_t)(b * 2048 + 8 * qo + (qr >> 2)) * 2048 + (g * 4 + (qr & 3)) * 64;
          op[r] = (bf16)(pk2(v0, 0.f) & 0xffffu); op[32 + r] = (bf16)(pk2(v1, 0.f) & 0xffffu); } }
}
DI void attn_sample_unit(Frame& F, int su) {
    const int lane = F.lane, r = lane & 31, h = lane >> 5, qi = r >> 2, rh = r & 3, w = F.wave;
    const int b = su >> 2, g = su & 3, t = 2048 + qi, row = MP + b * 8 + qi, hd = g * 4 + rh;
    const LAS float* lut = (const LAS float*)(F.lds + LUT_OFF);
    volatile LAS float* scr = (volatile LAS float*)(F.lds + w * 4096);
    LAS float* MB_ = (LAS float*)(F.lds + 32768);
    LAS float* OB = (LAS float*)(F.lds + 32768 + 2048);
    LAS float* OUT = (LAS float*)(F.lds + 32768 + 2048 + 65536);
    const bf16* QB = wsp<bf16>(F, WS_QB);
    bf16x8 qf[4];
#pragma unroll
    for (int step = 0; step < 4; ++step) qf[step] = *(const bf16x8*)(QB + (size_t)row * 1024 + hd * 64 + step * 16 + h * 8);
    f32x16 oc0, oc1;
    const int unit = 16 + su;
    const unsigned long long mask = cmp_branch(qf, wsp<bf16>(F, WS_KCK) + (size_t)unit * 8192, wsp<bf16>(F, WS_KCVT) + (size_t)unit * 8192, t, hd, lut, 33, scr, oc0, oc1, lane);
    unsigned long long om = mask;
#pragma unroll
    for (int o = 4; o < 32; o <<= 1) om |= __shfl_xor(om, o);
    om = __shfl(om, 0);
    const float* GATE = wsp<float>(F, WS_GATE) + (size_t)row * 48;
    if (w == 0) { const float f0 = GATE[hd];
#pragma unroll
        for (int reg = 0; reg < 16; ++reg) { const int qr = crow(reg, h); const float a0 = __shfl(f0, qr); OUT[qr * 64 + r] = a0 * oc0[reg]; OUT[qr * 64 + 32 + r] = a0 * oc1[reg]; } }
#pragma unroll 1
    for (int br = 0; br < 2; ++br) {
        AState st; astate_init(st);
        if (br == 0) { MaskBias mb{t, mask, true, 0, 1 << 30, 2056, hd, lut}; const float* cache = inp(F, I_CKV); const int* ptb = F.pt + b * 16;
            for (int j = w; j < 33; j += 8) { if (!((om >> j) & 1ull)) continue;
                KVf32 kv; kv.stride_b = 4096; kv.koff_b = (2 * 256 + g * 64) * 4; kv.voff_b = (3 * 256 + g * 64) * 4;
                if (j < 32) { const int page = __builtin_amdgcn_readfirstlane(ptb[j >> 1]); kv.rs = __builtin_amdgcn_make_buffer_rsrc((void*)(cache + ((size_t)page * 128 + (j & 1) * 64) * 1024), 0, 64 * 4096, 0x00020000); }
                else kv.rs = __builtin_amdgcn_make_buffer_rsrc((void*)(F.out + O_KVS + (size_t)b * 8 * 1024), 0, 8 * 4096, 0x00020000);
                attn_half_f32(st, qf, kv, j, 0, mb, r, h); attn_half_f32(st, qf, kv, j, 1, mb, r, h); } }
        else { MaskBias mb{t, 0ull, false, 1536, 512, 520, hd, lut};
            for (int j = (w == 7 ? 7 : w); j < 9; j += (w == 7 ? 1 : 16)) {
                KVf32 kv; kv.stride_b = 2048; kv.koff_b = (g * 64) * 4; kv.voff_b = (256 + g * 64) * 4;
                if (j < 8) kv.rs = __builtin_amdgcn_make_buffer_rsrc((void*)(inp(F, I_CWIN) + (size_t)b * 512 * 512 + (size_t)(64 * j) * 512), 0, 64 * 2048, 0x00020000);
                else kv.rs = __builtin_amdgcn_make_buffer_rsrc((void*)(F.out + O_WINS + (size_t)b * 512 * 512 + (size_t)504 * 512), 0, 8 * 2048, 0x00020000);
                attn_half_f32(st, qf, kv, j, 0, mb, r, h); attn_half_f32(st, qf, kv, j, 1, mb, r, h); } }
        __syncthreads();
        if (h == 0) { MB_[w * 32 + r] = st.m; MB_[256 + w * 32 + r] = st.l; }
#pragma unroll
        for (int reg = 0; reg < 16; ++reg) { const int qr = crow(reg, h); OB[(w * 32 + qr) * 64 + r] = st.o0[reg]; OB[(w * 32 + qr) * 64 + 32 + r] = st.o1[reg]; }
        __syncthreads();
        { const int qr = F.tid >> 4, d4 = (F.tid & 15) * 4; float M = NEGF;
#pragma unroll
          for (int ww = 0; ww < 8; ++ww) M = fmaxf(M, MB_[ww * 32 + qr]);
          float L = 0.f; f32x4 O = {0.f, 0.f, 0.f, 0.f};
#pragma unroll
          for (int ww = 0; ww < 8; ++ww) { const float e = __builtin_amdgcn_exp2f(MB_[ww * 32 + qr] - M); L += MB_[256 + ww * 32 + qr] * e; O += *(const LAS f32x4*)(OB + (ww * 32 + qr) * 64 + d4) * e; }
          const float gt = wsp<float>(F, WS_GATE)[(size_t)(MP + b * 8 + (qr >> 2)) * 48 + (br + 1) * 16 + g * 4 + (qr & 3)] / fmaxf(L, TINYF);
          *(LAS f32x4*)(OUT + qr * 64 + d4) += O * gt; }
    }
    __syncthreads();
    { const int qr = F.tid >> 4, d4 = (F.tid & 15) * 4; const f32x4 v = *(const LAS f32x4*)(OUT + qr * 64 + d4);
      u32x2 o; o.x = pk2(v.x, v.y); o.y = pk2(v.z, v.w); *(u32x2*)(wsp<bf16>(F, WS_MIX) + (size_t)(MP + b * 8 + (qr >> 2)) * 2048 + (g * 4 + (qr & 3)) * 64 + d4) = o; }
    __syncthreads();
}

struct KVlds {
    const LAS unsigned char* kimg; const LAS unsigned char* vimg;
    DI bf16x8 kfrag(int kh, int step, int r, int h) const { return *(const LAS bf16x8*)(kimg + (kh * 32 + r) * 144 + (step * 16 + h * 8) * 2); }
    DI bf16x8 vfrag(int kh, int s, int dg, int r, int h) const { const LAS unsigned char* p = vimg + (dg * 32 + r) * 136 + (kh * 32 + s * 16 + h * 4) * 2;
        const s16x4 lo = *(const LAS s16x4*)p, hi = *(const LAS s16x4*)(p + 16); return __builtin_shufflevector(lo, hi, 0, 1, 2, 3, 4, 5, 6, 7); }
};
DI void attn_tile_lds(AState& st, const bf16x8 (&qf)[4], const KVlds& kv, int tile, const MaskBias& mb, int r, int h, bool far) {
    f32x16 s0 = (f32x16){}, s1 = (f32x16){};
#pragma unroll
    for (int step = 0; step < 4; ++step) { s0 = MFMA32(kv.kfrag(0, step, r, h), qf[step], s0); s1 = MFMA32(kv.kfrag(1, step, r, h), qf[step], s1); }
    float tmax = NEGF; const bool sb = mb.selbit(tile);
    if (far) { const float cf = mb.lut[127 * 16 + mb.hd];
#pragma unroll
        for (int reg = 0; reg < 16; ++reg) { s0[reg] = sb ? s0[reg] * SCL2 + cf : NEGF; s1[reg] = sb ? s1[reg] * SCL2 + cf : NEGF; tmax = fmaxf(tmax, fmaxf(s0[reg], s1[reg])); } }
    else {
#pragma unroll
        for (int reg = 0; reg < 16; ++reg) { const int kk = crow(reg, h); s0[reg] = mb.score(s0[reg], tile, kk, sb); s1[reg] = mb.score(s1[reg], tile, 32 + kk, sb); tmax = fmaxf(tmax, fmaxf(s0[reg], s1[reg])); } }
    tmax = fmaxf(tmax, __shfl_xor(tmax, 32));
    const bool grow = __any(tmax > st.m + 8.0f);
    const float mnew = grow ? fmaxf(st.m, tmax) : st.m, alpha = grow ? __builtin_amdgcn_exp2f(st.m - mnew) : 1.0f;
    float ls = 0.f;
    const float msub = fmaxf(mnew, -1e29f);
#pragma unroll
    for (int reg = 0; reg < 16; ++reg) { const float p0 = __builtin_amdgcn_exp2f(s0[reg] - msub), p1 = __builtin_amdgcn_exp2f(s1[reg] - msub); s0[reg] = p0; s1[reg] = p1; ls += p0 + p1; }
    ls += __shfl_xor(ls, 32);
    st.l = st.l * alpha + ls; st.m = mnew;
    if (grow && __any(alpha != 1.0f)) {
#pragma unroll
        for (int reg = 0; reg < 16; ++reg) { const float a = __shfl(alpha, crow(reg, h)); st.o0[reg] *= a; st.o1[reg] *= a; }
    }
#pragma unroll
    for (int s = 0; s < 2; ++s) { const bf16x8 pf = pack8(s0, s); st.o0 = MFMA32(pf, kv.vfrag(0, s, 0, r, h), st.o0); st.o1 = MFMA32(pf, kv.vfrag(0, s, 1, r, h), st.o1); }
#pragma unroll
    for (int s = 0; s < 2; ++s) { const bf16x8 pf = pack8(s1, s); st.o0 = MFMA32(pf, kv.vfrag(1, s, 0, r, h), st.o0); st.o1 = MFMA32(pf, kv.vfrag(1, s, 1, r, h), st.o1); }
}
DI void attn_prompt_block(Frame& F, int blk) {
    const int lane = F.lane, r = lane & 31, h = lane >> 5, qi = r >> 2, rh = r & 3, w = F.wave, tid = F.tid;
    const int bg = blk >> 5, qb = blk & 31, b = bg >> 2, g = bg & 3, qo = 8 * qb + w, t = 8 * qo + qi, row = b * 2048 + t, hd = g * 4 + rh;
    const LAS float* lut = (const LAS float*)(F.lds + LUT_OFF);
    volatile LAS float* scr = (volatile LAS float*)(F.lds + w * 3328);
    LAS unsigned char* img = F.lds + 26624;
    volatile LAS float* ost = (volatile LAS float*)(F.lds + 62464 + w * 8192);
    const bf16* QB = wsp<bf16>(F, WS_QB);
    bf16x8 qf[4];
#pragma unroll
    for (int step = 0; step < 4; ++step) qf[step] = *(const bf16x8*)(QB + (size_t)row * 1024 + hd * 64 + step * 16 + h * 8);
    unsigned long long mask;
    { f32x16 oc0, oc1;
      if ((DBL >> 25) & 1) { const unsigned long long m0 = cmp_branch(qf, wsp<bf16>(F, WS_KCK) + (size_t)bg * 8192, wsp<bf16>(F, WS_KCVT) + (size_t)bg * 8192, t, hd, lut, 32, scr, oc0, oc1, lane); asm volatile("" :: "v"((unsigned)m0), "v"(oc0[0]), "v"(oc1[5])); }
      mask = cmp_branch(qf, wsp<bf16>(F, WS_KCK) + (size_t)bg * 8192, wsp<bf16>(F, WS_KCVT) + (size_t)bg * 8192, t, hd, lut, 32, scr, oc0, oc1, lane);
      const float f0 = wsp<float>(F, WS_GATE)[(size_t)row * 48 + hd];
#pragma unroll
      for (int reg = 0; reg < 16; ++reg) { const float a0 = __shfl(f0, crow(reg, h)); ost[(reg * 2) * 64 + lane] = a0 * oc0[reg]; ost[(reg * 2 + 1) * 64 + lane] = a0 * oc1[reg]; } }
    unsigned long long om = mask;
#pragma unroll
    for (int o = 4; o < 32; o <<= 1) om |= __shfl_xor(om, o);
    om = __shfl(om, 0);
    const int j0 = qb > 8 ? qb - 8 : 0, nsel = qb + 1, ntile = nsel + (qb - j0 + 1);
    const bf16* Ksel = wsp<bf16>(F, WS_KB) + (size_t)((b * 2 + 0) * 4 + g) * 2048 * 64; const bf16* Vsel = wsp<bf16>(F, WS_VT) + (size_t)((b * 2 + 0) * 4 + g) * 64 * 2048;
    const bf16* Kwin = wsp<bf16>(F, WS_KB) + (size_t)((b * 2 + 1) * 4 + g) * 2048 * 64; const bf16* Vwin = wsp<bf16>(F, WS_VT) + (size_t)((b * 2 + 1) * 4 + g) * 64 * 2048;
    u32x4 kreg, vreg;
#define APB_LOAD(i_) do { const bool ws_ = (i_) >= nsel; const int j_ = ws_ ? j0 + ((i_) - nsel) : (i_); \
        kreg = *(const u32x4*)((ws_ ? Kwin : Ksel) + (size_t)j_ * 4096 + tid * 8); vreg = *(const u32x4*)((ws_ ? Vwin : Vsel) + (size_t)(tid >> 3) * 2048 + j_ * 64 + (tid & 7) * 8); } while (0)
#define APB_STORE(buf_) do { LAS unsigned char* d_ = img + (buf_) * 17920; *(LAS u32x4*)(d_ + (tid >> 3) * 144 + (tid & 7) * 16) = kreg; \
        LAS unsigned char* v_ = d_ + 9216 + (tid >> 3) * 136 + (tid & 7) * 16; *(LAS u32x2*)v_ = (u32x2){kzero ? 0u : vreg.x, vreg.y}; *(LAS u32x2*)(v_ + 8) = (u32x2){vreg.z, vreg.w}; } while (0)
    const bool kzero = false;
    __syncthreads();
    APB_LOAD(0); APB_STORE(0);
    __syncthreads();
    AState st; astate_init(st);
    MaskBias mbs{t, mask, true, 0, 1 << 30, 1 << 30, hd, lut}, mbw{t, 0ull, false, 0, 512, 1 << 30, hd, lut};
    const float* GATE = wsp<float>(F, WS_GATE) + (size_t)row * 48;
#pragma unroll 1
    for (int i = 0; i < ntile; ++i) {
        if (i + 1 < ntile) APB_LOAD(i + 1);
        __builtin_amdgcn_sched_barrier(0);
        if (i == nsel) {
            const float f1 = GATE[16 + hd] / fmaxf(st.l, TINYF);
#pragma unroll
            for (int reg = 0; reg < 16; ++reg) { const float a1 = __shfl(f1, crow(reg, h)); ost[(reg * 2) * 64 + lane] += a1 * st.o0[reg]; ost[(reg * 2 + 1) * 64 + lane] += a1 * st.o1[reg]; }
            astate_init(st); }
        { const LAS unsigned char* d = img + (i & 1) * 17920; KVlds kv{d, d + 9216};
          if ((DBL >> 26) & 1) { AState d2; astate_init(d2); if (i < nsel) { if ((om >> i) & 1ull) attn_tile_lds(d2, qf, kv, i, mbs, r, h, 64 * i <= 8 * qo - 176); } else { const int j = j0 + (i - nsel); attn_tile_lds(d2, qf, kv, j, mbw, r, h, (64 * j <= 8 * qo - 176) && (64 * j >= 8 * qo - 505)); } asm volatile("" :: "v"(d2.l), "v"(d2.o0[0]), "v"(d2.o1[7])); }
          if (i < nsel) { if ((om >> i) & 1ull) attn_tile_lds(st, qf, kv, i, mbs, r, h, 64 * i <= 8 * qo - 176); }
          else { const int j = j0 + (i - nsel); attn_tile_lds(st, qf, kv, j, mbw, r, h, (64 * j <= 8 * qo - 176) && (64 * j >= 8 * qo - 505)); } }
        if (i + 1 < ntile) APB_STORE((i + 1) & 1);
        __syncthreads();
    }
#undef APB_LOAD
#undef APB_STORE
    { const float f2 = GATE[32 + hd] / fmaxf(st.l, TINYF);
      bf16* MIX = wsp<bf16>(F, WS_MIX);
#pragma unroll
      for (int reg = 0; reg < 16; ++reg) { const int qr = crow(reg, h); const float a2 = __shfl(f2, qr);
          const float v0 = ost[(reg * 2) * 64 + lane] + a2 * st.o0[reg], v1 = ost[(reg * 2 + 1) * 64 + lane] + a2 * st.o1[reg];
          bf16* op = MIX + (size_t)(b * 2048 + 8 * qo + (qr >> 2)) * 2048 + (g * 4 + (qr & 3)) * 64;
          op[r] = (bf16)(pk2(v0, 0.f) & 0xffffu); op[32 + r] = (bf16)(pk2(v1, 0.f) & 0xffffu); } }
}

DI void ssd_chunk_unit(Frame& F, int u) {
    const int lane = F.lane, r = lane & 31, h = lane >> 5, w = F.wave, tid = F.tid;
    const int g = u & 3, c = (u >> 2) & 15, b = u >> 6, row0 = b * 2048 + 128 * c;
    const float* XB = wsp<float>(F, WS_XBCC) + (size_t)row0 * 2048; const float* DTp = wsp<float>(F, WS_DT) + (size_t)row0 * 16;
    LAS float* acum = (LAS float*)F.lds;
    LAS float* dtv = acum + 512;
    LAS float* wexp = dtv + 512;
    LAS float* tot = wexp + 512;
    LAS unsigned char* Bb = F.lds + 8192;
    LAS unsigned char* XT = F.lds + 8192 + 128 * 272;
    __syncthreads();
    { f32x4 bv[8];
#pragma unroll
      for (int k = 0; k < 8; ++k) { const int f = tid + 512 * k; bv[k] = *(const f32x4*)(XB + (size_t)(f >> 5) * 2048 + 1024 + g * 128 + 4 * (f & 31)); }
      { const int hh = w >> 1, half = w & 1, i = 64 * half + lane, head = 4 * g + hh;
        const float A = -__expf(inp(F, I_ALOG)[head]); const float d = DTp[i * 16 + head];
        float a = d * A;
#pragma unroll
        for (int o = 1; o < 64; o <<= 1) { const float t = __shfl_up(a, o); if (lane >= o) a += t; }
        acum[hh * 128 + i] = a; dtv[hh * 128 + i] = d; if (lane == 63) tot[w] = a; }
#pragma unroll
      for (int k = 0; k < 8; ++k) { const int f = tid + 512 * k; u32x2 p; p.x = pk2(bv[k].x, bv[k].y); p.y = pk2(bv[k].z, bv[k].w); *(LAS u32x2*)(Bb + (f >> 5) * 272 + (f & 31) * 8) = p; } }
    __syncthreads();
    if (w & 1) acum[(w >> 1) * 128 + 64 + lane] += tot[w - 1];
    __syncthreads();
    { const int hh = tid >> 7, i = tid & 127; const float v = acum[hh * 128 + i];
      wsp<float>(F, WS_ACUM)[(size_t)(row0 + i) * 16 + 4 * g + hh] = v; if (i == 127) wsp<float>(F, WS_ATOT)[(b * 16 + c) * 16 + 4 * g + hh] = v;
      wexp[hh * 128 + i] = __expf(acum[hh * 128 + 127] - v); }
#pragma unroll 4
    for (int k = 0; k < 16; ++k) { const int f = tid + 512 * k, j = f >> 6, hp0 = 4 * (f & 63); const f32x4 xv = *(const f32x4*)(XB + (size_t)j * 2048 + (4 * g) * 64 + hp0); const float d = dtv[(hp0 >> 6) * 128 + j];
        LAS bf16* xp = (LAS bf16*)(XT + hp0 * 272) + j; const unsigned p0 = pk2(xv.x * d, xv.y * d), p1 = pk2(xv.z * d, xv.w * d);
        xp[0] = (bf16)(p0 & 0xffffu); xp[136] = (bf16)(p0 >> 16); xp[272] = (bf16)(p1 & 0xffffu); xp[408] = (bf16)(p1 >> 16); }
    __syncthreads();
    { const int it = w & 3, hp = w >> 2, i = 32 * it + r;
      const float ai0 = acum[(2 * hp) * 128 + i], ai1 = acum[(2 * hp + 1) * 128 + i];
      bf16x8 cf[8];
#pragma unroll
      for (int ks = 0; ks < 8; ++ks) { const float* p = XB + (size_t)i * 2048 + 1536 + g * 128 + 16 * ks + 8 * h; cf[ks] = cvt8(*(const f32x4*)p, *(const f32x4*)(p + 4)); }
      f32x16 Y00 = (f32x16){}, Y01 = (f32x16){}, Y10 = (f32x16){}, Y11 = (f32x16){};
#pragma unroll 1
      for (int jt = 0; jt <= it; ++jt) {
          f32x16 S = (f32x16){};
#pragma unroll
          for (int ks = 0; ks < 8; ++ks) S = MFMA32(*(const LAS bf16x8*)(Bb + (32 * jt + r) * 272 + (16 * ks + 8 * h) * 2), cf[ks], S);
#pragma unroll
          for (int e = 0; e < 2; ++e) { const int hh = 2 * hp + e; const float ai = e ? ai1 : ai0;
              f32x16 P;
#pragma unroll
              for (int reg = 0; reg < 16; ++reg) { const int j = 32 * jt + crow(reg, h); P[reg] = (j <= i) ? S[reg] * __expf(ai - acum[hh * 128 + j]) : 0.f; }
#pragma unroll
              for (int s = 0; s < 2; ++s) { const bf16x8 pf = pack8(P, s);
#pragma unroll
                  for (int dg = 0; dg < 2; ++dg) { const LAS unsigned char* vp = XT + (hh * 64 + 32 * dg + r) * 272 + (32 * jt + 16 * s + 4 * h) * 2;
                      const s16x4 lo = *(const LAS s16x4*)vp, hi = *(const LAS s16x4*)(vp + 16); const bf16x8 vf = __builtin_shufflevector(lo, hi, 0, 1, 2, 3, 4, 5, 6, 7);
                      if (e == 0) { if (dg == 0) Y00 = MFMA32(pf, vf, Y00); else Y01 = MFMA32(pf, vf, Y01); } else { if (dg == 0) Y10 = MFMA32(pf, vf, Y10); else Y11 = MFMA32(pf, vf, Y11); } } } }
      }
      float* YS = wsp<float>(F, WS_YSSM) + (size_t)row0 * 1024;
#pragma unroll
      for (int reg = 0; reg < 16; ++reg) { const int ii = 32 * it + crow(reg, h); float* yp = YS + (size_t)ii * 1024 + (4 * g + 2 * hp) * 64 + r;
          yp[0] = Y00[reg]; yp[32] = Y01[reg]; yp[64] = Y10[reg]; yp[96] = Y11[reg]; }
    }
    { const int hh = w >> 1, pt = w & 1, head = 4 * g + hh;
      f32x16 a0 = (f32x16){}, a1 = (f32x16){}, a2 = (f32x16){}, a3 = (f32x16){};
#pragma unroll 2
      for (int ks = 0; ks < 8; ++ks) {
          const u32x4 raw = *(const LAS u32x4*)(XT + (hh * 64 + 32 * pt + r) * 272 + (16 * ks + 8 * h) * 2);
          const LAS float* wp = wexp + hh * 128 + 16 * ks + 8 * h;
          u32x4 q;
          q.x = pk2(__uint_as_float(raw.x << 16) * wp[0], __uint_as_float(raw.x & 0xffff0000u) * wp[1]); q.y = pk2(__uint_as_float(raw.y << 16) * wp[2], __uint_as_float(raw.y & 0xffff0000u) * wp[3]);
          q.z = pk2(__uint_as_float(raw.z << 16) * wp[4], __uint_as_float(raw.z & 0xffff0000u) * wp[5]); q.w = pk2(__uint_as_float(raw.w << 16) * wp[6], __uint_as_float(raw.w & 0xffff0000u) * wp[7]);
          const bf16x8 af = __builtin_bit_cast(bf16x8, q);
#pragma unroll
          for (int nt = 0; nt < 4; ++nt) { const LAS bf16* bp = (const LAS bf16*)(Bb + (16 * ks + 8 * h) * 272) + 32 * nt + r; u32x4 q2;
              q2.x = (unsigned)bp[0] | ((unsigned)bp[136] << 16); q2.y = (unsigned)bp[272] | ((unsigned)bp[408] << 16); q2.z = (unsigned)bp[544] | ((unsigned)bp[680] << 16); q2.w = (unsigned)bp[816] | ((unsigned)bp[952] << 16);
              const bf16x8 bfr = __builtin_bit_cast(bf16x8, q2);
              if (nt == 0) a0 = MFMA32(af, bfr, a0); else if (nt == 1) a1 = MFMA32(af, bfr, a1); else if (nt == 2) a2 = MFMA32(af, bfr, a2); else a3 = MFMA32(af, bfr, a3); } }
      float* SC = wsp<float>(F, WS_SC) + ((size_t)((b * 16 + c) * 16 + head) * 64) * 128;
#pragma unroll
      for (int reg = 0; reg < 16; ++reg) { float* sp = SC + (size_t)(32 * pt + crow(reg, h)) * 128 + r; sp[0] = a0[reg]; sp[32] = a1[reg]; sp[64] = a2[reg]; sp[96] = a3[reg]; }
    }
}
DI void ssd_state_pass(Frame& F) {
    const int gt = F.vcu * NTHR + F.tid, NGT = F.G * NTHR;
    const float* SC = wsp<float>(F, WS_SC); const float* ATOT = wsp<float>(F, WS_ATOT); bf16* HP = wsp<bf16>(F, WS_HPREV);
    for (int e = gt; e < 131072; e += NGT) { const int b = e >> 15, rest = e & 32767, head = rest >> 11;
        f32x4 hs = {0.f, 0.f, 0.f, 0.f};
#pragma unroll 4
        for (int c = 0; c < 16; ++c) { const size_t off = ((size_t)(b * 16 + c) * 32768 + rest) * 4;
            u32x2 o; o.x = pk2(hs.x, hs.y); o.y = pk2(hs.z, hs.w); *(u32x2*)(HP + off) = o;
            hs = hs * __expf(ATOT[(b * 16 + c) * 16 + head]) + *(const f32x4*)(SC + off); }
        *(f32x4*)(F.out + O_SSP + ((size_t)b * 32768 + rest) * 4) = hs; }
}
DI void ssd_out_unit(Frame& F, int u) {
    const int lane = F.lane, r = lane & 31, h = lane >> 5, w = F.wave;
    const int g = u & 3, c = (u >> 2) & 15, b = u >> 6, row0 = b * 2048 + 128 * c;
    const int hh = w >> 1, ih = w & 1, head = 4 * g + hh;
    const float* XB = wsp<float>(F, WS_XBCC) + (size_t)row0 * 2048;
    const bf16* HP = wsp<bf16>(F, WS_HPREV) + ((size_t)((b * 16 + c) * 16 + head) * 64) * 128;
    LAS float* part = (LAS float*)F.lds;
    f32x16 acc[2][2];
#pragma unroll
    for (int a = 0; a < 2; ++a)
#pragma unroll
        for (int d = 0; d < 2; ++d) acc[a][d] = (f32x16){};
#pragma unroll 2
    for (int ks = 0; ks < 8; ++ks) {
        const bf16x8 h0 = *(const bf16x8*)(HP + (size_t)r * 128 + 16 * ks + 8 * h), h1 = *(const bf16x8*)(HP + (size_t)(32 + r) * 128 + 16 * ks + 8 * h);
#pragma unroll
        for (int a = 0; a < 2; ++a) { const float* p = XB + (size_t)(64 * ih + 32 * a + r) * 2048 + 1536 + g * 128 + 16 * ks + 8 * h; const bf16x8 cfr = cvt8(*(const f32x4*)p, *(const f32x4*)(p + 4));
            acc[a][0] = MFMA32(cfr, h0, acc[a][0]); acc[a][1] = MFMA32(cfr, h1, acc[a][1]); } }
    const float* YS = wsp<float>(F, WS_YSSM) + (size_t)row0 * 1024; const float* ZF = wsp<float>(F, WS_ZF) + (size_t)row0 * 1024; const float* AC = wsp<float>(F, WS_ACUM) + (size_t)row0 * 16;
    const float D = inp(F, I_SD)[head];
    __syncthreads();
    int ib = 64 * ih + 4 * h;
#pragma unroll
    for (int a = 0; a < 2; ++a)
#pragma unroll
        for (int reg = 0; reg < 16; ++reg) { if ((reg & 7) == 0) asm volatile("" : "+v"(ib) :: "memory"); const int i = ib + 32 * a + (reg & 3) + 8 * (reg >> 2); const float ea = __expf(AC[i * 16 + head]); float ssq = 0.f;
#pragma unroll
            for (int d = 0; d < 2; ++d) { const int col = head * 64 + 32 * d + r; float y = YS[(size_t)i * 1024 + col] + ea * acc[a][d][reg] + D * XB[(size_t)i * 2048 + col]; y *= siluf_(ZF[(size_t)i * 1024 + col]); acc[a][d][reg] = y; ssq += y * y; }
            ssq += __shfl_xor(ssq, 1); ssq += __shfl_xor(ssq, 2); ssq += __shfl_xor(ssq, 4); ssq += __shfl_xor(ssq, 8); ssq += __shfl_xor(ssq, 16);
            if (r == 0) part[hh * 128 + i] = ssq; }
    __syncthreads();
    bf16* MIX = wsp<bf16>(F, WS_MIX) + (size_t)row0 * 2048 + 1024;
    const float g0 = inp(F, I_SNG)[head * 64 + r], g1 = inp(F, I_SNG)[head * 64 + 32 + r];
#pragma unroll
    for (int a = 0; a < 2; ++a)
#pragma unroll
        for (int reg = 0; reg < 16; ++reg) { if ((reg & 3) == 0) asm volatile("" : "+v"(ib) :: "memory"); const int i = ib + 32 * a + (reg & 3) + 8 * (reg >> 2);
            const float ss = (part[i] + part[128 + i]) + (part[256 + i] + part[384 + i]); const float rs = 1.0f / sqrtf(ss * (1.f / 256.f) + EPS);
            bf16* op = MIX + (size_t)i * 2048 + head * 64 + r;
            op[0] = (bf16)(pk2(acc[a][0][reg] * rs * g0, 0.f) & 0xffffu); op[32] = (bf16)(pk2(acc[a][1][reg] * rs * g1, 0.f) & 0xffffu); }
}

#ifndef BWPROBE
#define BWPROBE 0
#endif
#if BWPROBE > 0
DI void bw_probe(Frame& F) {
    const int tid = F.tid; const float* cache = inp(F, I_CKV); f32x4 acc = {0.f, 0.f, 0.f, 0.f};
#if BWPROBE == 6
    for (int hu = F.vcu; hu < 1024; hu += F.G) { const int b = hu >> 3, kv = (hu >> 2) & 1, mt = hu & 3;
        for (int s = 0; s < 16; ++s) {
#pragma unroll
            for (int k = 0; k < 4; ++k) { int f = tid + 512 * k; asm volatile("" : "+v"(f)); const int row = 32 * mt + (f >> 6);
                const float* p = cache + ((size_t)F.pt[b * 16 + (row >> 3)] * 128 + (row & 7) * 16 + s) * 1024 + kv * 256 + (f & 63) * 4;
                acc += *(const f32x4*)p; }
        } }
#elif BWPROBE == 7
    for (int hu = F.vcu; hu < 1024; hu += F.G) { const int b = hu >> 3, cb = hu & 7;
        for (int s = 0; s < 16; ++s) {
#pragma unroll
            for (int k = 0; k < 5; ++k) { int f = tid + 512 * k; asm volatile("" : "+v"(f)); if (f < 17 * 128) { int row = 16 * cb + (f >> 7); row = row > 127 ? 127 : row;
                const float* p = cache + ((size_t)F.pt[b * 16 + (row >> 3)] * 128 + (row & 7) * 16 + s) * 1024 + (f & 127) * 4;
                acc += *(const f32x4*)p; } }
        } }
#else
#if BWPROBE == 8
    if (F.vcu & 1) return;
    for (int hu = F.vcu >> 1; hu < 1024; hu += F.G / 2) { const int unit = hu >> 1, kv = hu & 1, b = unit >> 2, g = unit & 3;
#else
    for (int hu = F.vcu; hu < 1024; hu += F.G) { const int unit = hu >> 1, kv = hu & 1, b = unit >> 2, g = unit & 3;
#endif
        for (int s = 0; s < 16; ++s) {
#pragma unroll
            for (int k = 0; k < 4; ++k) {
#if BWPROBE == 1 || BWPROBE == 8
                int idx = (tid >> 4) + 32 * k; asm volatile("" : "+v"(idx)); const int row = idx, ss = s;
#else
                const int idx = (tid >> 4) + 32 * k; const int row = 8 * s + (idx >> 4), ss = idx & 15;
#endif
                const float* p = cache + ((size_t)F.pt[b * 16 + (row >> 3)] * 128 + (row & 7) * 16 + ss) * 1024 + kv * 256 + g * 64 + (tid & 15) * 4;
                acc += *(const f32x4*)p; }
        } }
#endif
    if (acc.x == 1.2345e38f) wsp<float>(F, WS_FFN)[tid] = acc.y + acc.z + acc.w;
}
#endif

template <int CTRL> DI float ror16(float x) { return __int_as_float(__builtin_amdgcn_mov_dpp(__float_as_int(x), CTRL, 0xf, 0xf, true)); }
struct EpiAct {
    static constexpr bool PERM = true, AFTER_DRAIN = false;
    unsigned char* ws; float* out; const float* dww; const float* dwb; const float* hist; LAS float* xb;
    __device__ __forceinline__ void operator()(const pg8::f32x4 (&acc)[2][2][4][2], const pg8::Unit& u, int wr, int wc, int fr, int fq) const {
        bf16* const ACT = (bf16*)(ws + WS_ACT); float* const HALO = (float*)(ws + WS_HALO); float* const FIXG = (float*)(ws + WS_FIXG); float* const FIXU = (float*)(ws + WS_FIXU);
        const int cloc = wc * 32 + fq * 8, ch0 = u.pn * 128 + cloc, pm = u.pm;
        const bool live = ch0 < DFF, isp = pm < 32, seqstart = isp && ((pm & 7) == 0);
        if (fr >= 14) {
#pragma unroll
            for (int ai = 0; ai < 2; ++ai)
#pragma unroll
                for (int n = 0; n < 2; ++n) *(LAS f32x4*)(xb + ((2 * ai + wr) * 2 + (fr - 14)) * 128 + cloc + 4 * n) = acc[ai][0][3][n]; }
        asm volatile("s_waitcnt lgkmcnt(0)" ::: "memory"); __builtin_amdgcn_s_barrier(); asm volatile("" ::: "memory");
        f32x4 w0[2], w1[2], w2[2], bb[2];
#pragma unroll
        for (int n = 0; n < 2; ++n) { const int c = live ? ch0 + 4 * n : 0; w0[n] = *(const f32x4*)(dww + c); w1[n] = *(const f32x4*)(dww + DFF + c); w2[n] = *(const f32x4*)(dww + 2 * DFF + c); bb[n] = *(const f32x4*)(dwb + c); }
#pragma unroll
        for (int ai = 0; ai < 2; ++ai) {
            const int blk = 2 * ai + wr;
            f32x4 P1[2], P2[2];
#pragma unroll
            for (int n = 0; n < 2; ++n) { if (blk > 0) { P1[n] = *(const LAS f32x4*)(xb + ((blk - 1) * 2 + 1) * 128 + cloc + 4 * n); P2[n] = *(const LAS f32x4*)(xb + ((blk - 1) * 2 + 0) * 128 + cloc + 4 * n); }
                                          else { P1[n] = (f32x4){0.f, 0.f, 0.f, 0.f}; P2[n] = (f32x4){0.f, 0.f, 0.f, 0.f}; } }
#pragma unroll
            for (int m = 0; m < 4; ++m) {
                const int row = pm * 256 + ai * 128 + wr * 64 + m * 16 + fr;
                u32x4 pk;
#pragma unroll
                for (int n = 0; n < 2; ++n) {
                    const f32x4 G0 = acc[ai][0][m][n], U = acc[ai][1][m][n]; f32x4 G1, G2;
#pragma unroll
                    for (int e = 0; e < 4; ++e) {
                        const float a1 = ror16<0x121>(G0[e]), a2 = ror16<0x122>(G0[e]); float b1, b2;
                        if (m > 0) { b1 = ror16<0x121>(acc[ai][0][m > 0 ? m - 1 : 0][n][e]); b2 = ror16<0x122>(acc[ai][0][m > 0 ? m - 1 : 0][n][e]); }
                        else { b1 = P1[n][e]; b2 = (fr == 0) ? P2[n][e] : P1[n][e]; }
                        G1[e] = fr >= 1 ? a1 : b1; G2[e] = fr >= 2 ? a2 : b2; }
                    if (!isp && live) { const int t = fr & 7, b = (row - MP) >> 3;
                        if (t == 0) { G1 = *(const f32x4*)(hist + ((size_t)b * 2 + 1) * DFF + ch0 + 4 * n); G2 = *(const f32x4*)(hist + ((size_t)b * 2 + 0) * DFF + ch0 + 4 * n); }
                        else if (t == 1) G2 = *(const f32x4*)(hist + ((size_t)b * 2 + 1) * DFF + ch0 + 4 * n); }
                    const f32x4 cv = bb[n] + w0[n] * G2 + w1[n] * G1 + w2[n] * G0;
                    f32x4 a; a.x = gelu_tanh(cv.x) * U.x; a.y = gelu_tanh(cv.y) * U.y; a.z = gelu_tanh(cv.z) * U.z; a.w = gelu_tanh(cv.w) * U.w;
                    if (!live) a = (f32x4){0.f, 0.f, 0.f, 0.f};
                    if (n == 0) { pk.x = pk2(a.x, a.y); pk.y = pk2(a.z, a.w); } else { pk.z = pk2(a.x, a.y); pk.w = pk2(a.z, a.w); }
                    if (live) {
                        const int tl = isp ? (row & 2047) - (TP - 2) : (row & 7) - (TS - 2);
                        if (tl >= 0) { const int b = isp ? (row >> 11) : ((row - MP) >> 3); *(f32x4*)((isp ? out + O_FCP : out + O_FCS) + ((size_t)b * 2 + tl) * DFF + ch0 + 4 * n) = G0; }
                        if (isp) {
                            if (blk == 3 && m == 3 && fr >= 14) *(f32x4*)(HALO + ((size_t)pm * 2 + (fr - 14)) * DFFP + ch0 + 4 * n) = G0;
                            if (blk == 0 && m == 0 && fr < 2) { *(f32x4*)(FIXG + ((size_t)pm * 2 + fr) * DFFP + ch0 + 4 * n) = G0; *(f32x4*)(FIXU + ((size_t)pm * 2 + fr) * DFFP + ch0 + 4 * n) = U; } } }
                }
                const bool deferred = live && isp && !seqstart && blk == 0 && m == 0 && fr < 2;
                if (!deferred) *(u32x4*)(ACT + (size_t)row * DFFP + ch0) = pk;
            }
        }
        asm volatile("s_waitcnt lgkmcnt(0)" ::: "memory"); __builtin_amdgcn_s_barrier(); asm volatile("" ::: "memory");
    }
};
DI void act_fixup(Frame& F, int pm) {
    if (pm >= 32 || (pm & 7) == 0) return;
    const float* HALO = wsp<float>(F, WS_HALO); const float* FIXG = wsp<float>(F, WS_FIXG); const float* FIXU = wsp<float>(F, WS_FIXU); bf16* ACT = wsp<bf16>(F, WS_ACT);
    const float* dww = inp(F, I_DWW); const float* dwb = inp(F, I_DWB);
    int c4 = F.tid; asm volatile("" : "+v"(c4));
    for (int c = c4 * 4; c < DFF; c += NTHR * 4) {
        const f32x4 gm2 = *(const f32x4*)(HALO + ((size_t)(pm - 1) * 2 + 0) * DFFP + c), gm1 = *(const f32x4*)(HALO + ((size_t)(pm - 1) * 2 + 1) * DFFP + c);
        const f32x4 g0 = *(const f32x4*)(FIXG + ((size_t)pm * 2 + 0) * DFFP + c), g1 = *(const f32x4*)(FIXG + ((size_t)pm * 2 + 1) * DFFP + c);
        const f32x4 u0 = *(const f32x4*)(FIXU + ((size_t)pm * 2 + 0) * DFFP + c), u1 = *(const f32x4*)(FIXU + ((size_t)pm * 2 + 1) * DFFP + c);
        const f32x4 w0 = *(const f32x4*)(dww + c), w1 = *(const f32x4*)(dww + DFF + c), w2 = *(const f32x4*)(dww + 2 * DFF + c), bb = *(const f32x4*)(dwb + c);
        const f32x4 c0 = bb + w0 * gm2 + w1 * gm1 + w2 * g0, c1 = bb + w0 * gm1 + w1 * g0 + w2 * g1;
        u32x2 o0, o1; o0.x = pk2(gelu_tanh(c0.x) * u0.x, gelu_tanh(c0.y) * u0.y); o0.y = pk2(gelu_tanh(c0.z) * u0.z, gelu_tanh(c0.w) * u0.w);
        o1.x = pk2(gelu_tanh(c1.x) * u1.x, gelu_tanh(c1.y) * u1.y); o1.y = pk2(gelu_tanh(c1.z) * u1.z, gelu_tanh(c1.w) * u1.w);
        *(u32x2*)(ACT + (size_t)(pm * 256) * DFFP + c) = o0; *(u32x2*)(ACT + (size_t)(pm * 256 + 1) * DFFP + c) = o1; }
    VM_WAIT(); __syncthreads();
}

DI void ssm_item(Frame& F, int its) {
    const int b = its >> 4, head = its & 15, g = head >> 2;
    const int row0 = MP + b * TS;
    const int pl = F.tid >> 5, nc = F.tid & 31;
    const float* XBCC = wsp<float>(F, WS_XBCC); const float* DT = wsp<float>(F, WS_DT); float* YS = wsp<float>(F, WS_YSSM);
    const float A = -__expf(inp(F, I_ALOG)[head]);
    const size_t soff = ((size_t)(b * 16 + head) * 64 + pl) * 128 + 4 * nc;
    f32x4 hs[4];
#pragma unroll
    for (int pq = 0; pq < 4; ++pq) hs[pq] = *(const f32x4*)(inp(F, I_SSM) + soff + (size_t)pq * 16 * 128);
    const float* xr = XBCC + (size_t)row0 * 2048;
    float part[32];
#pragma unroll
    for (int t = 0; t < TS; ++t) {
        const float* rp = xr + (size_t)t * 2048;
        const float dtv = DT[(size_t)(row0 + t) * 16 + head], dA = __expf(dtv * A);
        const f32x4 Bv = *(const f32x4*)(rp + 1024 + g * 128 + 4 * nc), Cv = *(const f32x4*)(rp + 1536 + g * 128 + 4 * nc);
#pragma unroll
        for (int pq = 0; pq < 4; ++pq) { const float x = rp[head * 64 + 16 * pq + pl] * dtv;
            hs[pq] = hs[pq] * dA + Bv * x;
            part[t * 4 + pq] = (Cv.x * hs[pq].x + Cv.y * hs[pq].y) + (Cv.z * hs[pq].z + Cv.w * hs[pq].w); }
    }
#pragma unroll
    for (int o = 16, c = 32; o >= 1; o >>= 1, c >>= 1) { const bool up = (nc & o) != 0;
#pragma unroll
        for (int i = 0; i < 16; ++i) if (i < c / 2) { const float lo = part[i], hi = part[i + c / 2]; const float recv = __shfl_xor(up ? lo : hi, o); part[i] = (up ? hi : lo) + recv; } }
    YS[(size_t)(row0 + (nc >> 2)) * 1024 + head * 64 + 16 * (nc & 3) + pl] = part[0];
#pragma unroll
    for (int pq = 0; pq < 4; ++pq) *(f32x4*)(F.out + O_SSS + soff + (size_t)pq * 16 * 128) = hs[pq];
}
DI void ssm_post(Frame& F) {
    const float* YS = wsp<float>(F, WS_YSSM); const float* XBCC = wsp<float>(F, WS_XBCC); const float* ZF = wsp<float>(F, WS_ZF); bf16* MIX = wsp<bf16>(F, WS_MIX);
    const int gw = F.vcu * NWAVES + F.wave, NGW = F.G * NWAVES, lane = F.lane;
    for (int i = gw; i < MS * 4; i += NGW) { const int row = MP + (i >> 2), g = i & 3, c = g * 256 + lane * 4;
        const f32x4 y = *(const f32x4*)(YS + (size_t)row * 1024 + c), x = *(const f32x4*)(XBCC + (size_t)row * 2048 + c), z = *(const f32x4*)(ZF + (size_t)row * 1024 + c);
        const float D = inp(F, I_SD)[c >> 6];
        f32x4 v = y + x * D; v.x *= siluf_(z.x); v.y *= siluf_(z.y); v.z *= siluf_(z.z); v.w *= siluf_(z.w);
        const float ss = wave_sum((v.x * v.x + v.y * v.y) + (v.z * v.z + v.w * v.w));
        const float rs = 1.0f / sqrtf(ss * (1.f / 256.f) + EPS);
        const f32x4 gg = *(const f32x4*)(inp(F, I_SNG) + c);
        u32x2 o; o.x = pk2(v.x * rs * gg.x, v.y * rs * gg.y); o.y = pk2(v.z * rs * gg.z, v.w * rs * gg.w);
        *(u32x2*)(MIX + (size_t)row * 2048 + 1024 + c) = o; }
}
DI void norm1(Frame& F) {
    const bf16* MIXO = wsp<bf16>(F, WS_MIXO); float* X1 = wsp<float>(F, WS_X1); bf16* H = wsp<bf16>(F, WS_XN);
    const float* SLAB = wsp<float>(F, WS_SLAB); const unsigned* flg = (const unsigned*)(F.ws + WS_CTL) + CW_FLAG6;
    const int gw = F.vcu * NWAVES + F.wave, NGW = F.G * NWAVES; int lane = F.lane; asm volatile("" : "+v"(lane));
#pragma unroll 1
    for (int m = gw; m < MT; m += NGW) {
        asm volatile("" : "+v"(lane));
        const u32x2* mr = (const u32x2*)(MIXO + (size_t)m * DM) + lane; const f32x4* xr = (const f32x4*)(m < MP ? inp(F, I_XP) + (size_t)m * DM : inp(F, I_XS) + (size_t)(m - MP) * DM) + lane;
        const f32x4* g1 = (const f32x4*)inp(F, I_LNPOST) + lane; const f32x4* g2 = (const f32x4*)inp(F, I_LNFPRE) + lane;
        f32x4 v[8], xv[8]; float s = 0.f;
#pragma unroll
        for (int j = 0; j < 8; ++j) xv[j] = xr[64 * j];
#pragma unroll
        for (int j = 0; j < 8; ++j) { const u32x2 p = mr[64 * j]; v[j] = (f32x4){__uint_as_float(p.x << 16), __uint_as_float(p.x & 0xffff0000u), __uint_as_float(p.y << 16), __uint_as_float(p.y & 0xffff0000u)}; }
        const u32x4 fa = *(const u32x4*)(flg + (m >> 8) * 8), fb = *(const u32x4*)(flg + (m >> 8) * 8 + 4);
        if ((fa.x | fa.y | fa.z | fa.w | fb.x | fb.y | fb.z | fb.w) != 0u) { const unsigned fl[8] = {fa.x, fa.y, fa.z, fa.w, fb.x, fb.y, fb.z, fb.w};
#pragma unroll
            for (int j = 0; j < 8; ++j) if (fl[j]) { const f32x4* sl = (const f32x4*)(SLAB + (size_t)m * DM) + lane + 64 * j; v[j] = (sl[0] + sl[(size_t)MT * DM / 4]) + (sl[(size_t)2 * MT * DM / 4] + sl[(size_t)3 * MT * DM / 4]); } }
#pragma unroll
        for (int j = 0; j < 8; ++j) s += (v[j].x * v[j].x + v[j].y * v[j].y) + (v[j].z * v[j].z + v[j].w * v[j].w);
        const float rs = 1.0f / sqrtf(wave_sum(s) * (1.f / DM) + EPS); float s2 = 0.f;
#pragma unroll
        for (int j = 0; j < 8; ++j) { v[j] = xv[j] + v[j] * rs * g1[64 * j]; s2 += (v[j].x * v[j].x + v[j].y * v[j].y) + (v[j].z * v[j].z + v[j].w * v[j].w); ((f32x4*)(X1 + (size_t)m * DM) + lane)[64 * j] = v[j]; }
        const float rs2 = 1.0f / sqrtf(wave_sum(s2) * (1.f / DM) + EPS);
        u32x2* o8 = (u32x2*)(H + (size_t)m * DM) + lane;
#pragma unroll
        for (int j = 0; j < 8; ++j) { const f32x4 gg = g2[64 * j]; u32x2 w; w.x = pk2(v[j].x * rs2 * gg.x, v[j].y * rs2 * gg.y); w.y = pk2(v[j].z * rs2 * gg.z, v[j].w * rs2 * gg.w); o8[64 * j] = w; }
    }
}
DI void norm2(Frame& F) {
    const bf16* FFN = wsp<bf16>(F, WS_FFN); const float* X1 = wsp<float>(F, WS_X1);
    const float* SLAB = wsp<float>(F, WS_SLAB); const unsigned* flg = (const unsigned*)(F.ws + WS_CTL) + CW_FLAG10;
    const int gw = F.vcu * NWAVES + F.wave, NGW = F.G * NWAVES; int lane; asm volatile("v_and_b32 %0, 63, %1" : "=v"(lane) : "v"((int)threadIdx.x));
#pragma unroll 1
    for (int m = gw; m < MT; m += NGW) {
        const u32x2* fr_ = (const u32x2*)(FFN + (size_t)m * DM) + lane; const f32x4* xr = (const f32x4*)(X1 + (size_t)m * DM) + lane; const f32x4* g3 = (const f32x4*)inp(F, I_LNFPOST) + lane;
        f32x4 v[8], xv[8]; float s = 0.f;
#pragma unroll
        for (int j = 0; j < 8; ++j) xv[j] = xr[64 * j];
#pragma unroll
        for (int j = 0; j < 8; ++j) { const u32x2 p = fr_[64 * j]; v[j] = (f32x4){__uint_as_float(p.x << 16), __uint_as_float(p.x & 0xffff0000u), __uint_as_float(p.y << 16), __uint_as_float(p.y & 0xffff0000u)}; }
        const u32x4 fa = *(const u32x4*)(flg + (m >> 8) * 8), fb = *(const u32x4*)(flg + (m >> 8) * 8 + 4);
        if ((fa.x | fa.y | fa.z | fa.w | fb.x | fb.y | fb.z | fb.w) != 0u) { const unsigned fl[8] = {fa.x, fa.y, fa.z, fa.w, fb.x, fb.y, fb.z, fb.w};
#pragma unroll
            for (int j = 0; j < 8; ++j) if (fl[j]) { const f32x4* sl = (const f32x4*)(SLAB + (size_t)m * DM) + lane + 64 * j; v[j] = (sl[0] + sl[(size_t)MT * DM / 4]) + (sl[(size_t)2 * MT * DM / 4] + sl[(size_t)3 * MT * DM / 4]); } }
#pragma unroll
        for (int j = 0; j < 8; ++j) s += (v[j].x * v[j].x + v[j].y * v[j].y) + (v[j].z * v[j].z + v[j].w * v[j].w);
        const float rs = 1.0f / sqrtf(wave_sum(s) * (1.f / DM) + EPS);
        f32x4* o = (f32x4*)(F.out + (m < MP ? O_YP + (size_t)m * DM : O_YS + (size_t)(m - MP) * DM)) + lane;
#pragma unroll
        for (int j = 0; j < 8; ++j) o[64 * j] = xv[j] + v[j] * rs * g3[64 * j];
    }
}

struct RepOrder {
    pg8::StaticOrder base; int cnt, reps, maxi;
    __device__ __forceinline__ void init(int M, int N, int G, int c, int reps_) { base.init(M, N, G, c); cnt = (base.nwg - c + G - 1) / G; if (cnt < 0) cnt = 0; reps = reps_; maxi = 1 << 30; }
    __device__ __forceinline__ bool next(int i, pg8::Unit& u) const { const int cn = cnt < maxi ? cnt : maxi; if (i >= cn * reps) return false; return base.next(reps == 1 ? i : i % cn, u); }
    __device__ __forceinline__ void a_ready(const pg8::Unit&) const {}
    __device__ __forceinline__ void done(const pg8::Unit&) const {}
};
struct OneOrder {
    pg8::Unit u; bool ok;
    __device__ __forceinline__ void init(int M, int N, int G, int L) { pg8::StaticOrder b; b.init(M, N, G, L % G); ok = b.next(L / G, u); }
    __device__ __forceinline__ bool next(int i, pg8::Unit& o) const { if (i != 0 || !ok) return false; o = u; return true; }
    __device__ __forceinline__ void a_ready(const pg8::Unit&) const {}
    __device__ __forceinline__ void done(const pg8::Unit&) const {}
};
constexpr int N_PHASES = 13;
struct Args { const void* in[N_IN]; float* out; unsigned char* ws; int ph_lo, ph_hi, pad0, pad1; };
__global__ void __launch_bounds__(NTHR, 2) hybrid_fwd(Args args) {
    extern __shared__ __attribute__((aligned(16))) unsigned char lds[];
    Frame F;
    F.lds = (LAS unsigned char*)lds;
    F.tid = threadIdx.x; F.lane = F.tid & 63; F.wave = __builtin_amdgcn_readfirstlane(F.tid >> 6);
    F.G = gridDim.x; { const int bx = blockIdx.x; F.vcu = (F.G % 8 == 0) ? (bx % 8) * (F.G / 8) + bx / 8 : bx; }
    F.ptab = (LAS unsigned*)(F.lds + PTAB_OFF);
    F.pt = (const int*)args.in[I_PT]; F.out = args.out; F.ws = args.ws;
    unsigned* ctl = (unsigned*)(F.ws + WS_CTL);
    for (int u = F.tid; u < (LDS_BYTES - LDSCTL_OFF) / 4; u += NTHR) ((LAS unsigned*)(F.lds + LDSCTL_OFF))[u] = 0u;
    __syncthreads();
#pragma unroll
    for (int i = 0; i < N_IN; ++i) if (F.tid == i) { const unsigned long long p = (unsigned long long)args.in[i]; F.ptab[2 * i] = (unsigned)p; F.ptab[2 * i + 1] = (unsigned)(p >> 32); }
    __syncthreads();
    const int lo = args.ph_lo, hi = args.ph_hi;
#if PROBE_PH >= 0
    volatile LAS unsigned long long* stamps = (volatile LAS unsigned long long*)(F.lds + LDSCTL_OFF);
#define STAMP(i) do { if (blockIdx.x == 0 && F.tid == 0) stamps[i] = __builtin_amdgcn_s_memrealtime(); } while (0)
#else
#define STAMP(i) do {} while (0)
#endif
    STAMP(0);
    XcdBarrier bar; bar.bar = ctl + CW_BAR; bar.x = 0; bar.st = nullptr;
    if (hi - lo > 1) bar = xcd_barrier_post(ctl + CW_BAR, (volatile LAS unsigned*)(F.lds + MISC_OFF) + 8);
#ifndef PH3_MASK
#define PH3_MASK 15
#endif
#ifndef PH_MASK
#define PH_MASK 0x1fff
#endif
#define IN(k) (((PH_MASK >> (k)) & 1) && lo <= (k) && (k) < hi)
#define SEAM(k) do { if (IN(k) && IN((k) + 1)) { xcd_barrier(bar); if ((DBL >> 18) & 1) xcd_barrier(bar); } STAMP((k) + 1); } while (0)
    LAS unsigned char* ring = F.lds;

#define RN(bit) (1 + ((DBL >> (bit)) & 1))
#define REP(bit) for (int rep_ = 0; rep_ < RN(bit); ++rep_)
    if (IN(0)) { ph0_prologue(F, RN(15), RN(16), RN(17)); } SEAM(0);
    if (IN(1)) {
        pg8::Gemm gm{wsp<bf16>(F, WS_XN), wsp<bf16>(F, WS_WIN), MT, NPROJ, DM, DM}; RepOrder S; S.init(MT, NPROJ, F.G, (int)blockIdx.x, RN(1));
        EpiProj E{F.ws, F.out};
        pg8::gemm_phase<EpiProj, RepOrder, true, true>(ring, gm, S, E);
        if (F.G == 256 && blockIdx.x >= 60) compress_half(F, 32 + ((int)blockIdx.x - 60));
    } SEAM(1);
    if (IN(2)) { { const int nrem = (F.G == 256) ? 2 * NUNIT - 196 : 2 * NUNIT; for (int uu = F.vcu; uu < nrem * RN(2); uu += F.G) { const int j = uu % nrem; compress_half(F, (F.G == 256 && j >= 32) ? j + 196 : j); } } if (F.G == 256) { if (F.vcu >= 92) ssm_pre(F, F.vcu - 92, 164); } else ssm_pre(F, F.vcu, F.G); } SEAM(2);
    if (IN(3)) {
        { const float* LUT = wsp<float>(F, WS_LUT); LAS float* l = (LAS float*)(F.lds + LUT_OFF); int t0 = F.tid; asm volatile("" : "+v"(t0)); for (int i = t0; i < 2048; i += NTHR) l[i] = LUT[i] * LOG2E; }
        __syncthreads();
        if (PH3_MASK & 1) for (int uu = F.vcu; uu < 256 * RN(4); uu += F.G) ssd_chunk_unit(F, uu % 256);
        __syncthreads();
        if ((F.vcu & 1) == 0) {
            if (PH3_MASK & 2) for (int uu = F.vcu; uu < 256 * RN(5); uu += F.G) { const int u = uu % 256; attn_prompt_block(F, u); attn_prompt_block(F, 511 - u); }
            __syncthreads();
            if (PH3_MASK & 4) for (int uu = F.vcu; uu < 512 * RN(6); uu += F.G) attn_sample_unit(F, uu % 512);
            if (PH3_MASK & 8) for (int it = F.vcu; it < 2048 * RN(7); it += F.G) ssm_item(F, it % 2048);
        } else {
            if (PH3_MASK & 4) for (int uu = F.vcu; uu < 512 * RN(6); uu += F.G) attn_sample_unit(F, uu % 512);
            if (PH3_MASK & 8) for (int it = F.vcu; it < 2048 * RN(7); it += F.G) ssm_item(F, it % 2048);
            __syncthreads();
            if (PH3_MASK & 2) for (int uu = F.vcu; uu < 256 * RN(5); uu += F.G) { const int u = uu % 256; attn_prompt_block(F, u); attn_prompt_block(F, 511 - u); }
        }
    } SEAM(3);
    if (IN(4)) { REP(19) ssd_state_pass(F); REP(8) ssm_post(F); } SEAM(4);
    if (IN(5)) { for (int uu = F.vcu; uu < 256 * RN(20); uu += F.G) ssd_out_unit(F, uu % 256); } SEAM(5);
    if (IN(6)) {
        { pg8::Gemm gm{wsp<bf16>(F, WS_MIX), wsp<bf16>(F, WS_WOUT), MT, DM, DM, DM}; RepOrder S; S.init(MT, DM, F.G, (int)blockIdx.x, RN(9)); if (F.G == 256) S.maxi = 1;
          EpiBf16P E{wsp<bf16>(F, WS_MIXO), DM};
          pg8::gemm_phase<EpiBf16P, RepOrder, true, true>(ring, gm, S, E); }
        if (F.G == 256 && blockIdx.x < 128) { const int kp = blockIdx.x & 3;
          pg8::Gemm gm{wsp<bf16>(F, WS_MIX) + kp * (DM / 4), wsp<bf16>(F, WS_WOUT) + kp * (DM / 4), MT, DM, DM, DM / 4}; OneOrder S; S.init(MT, DM, F.G, 256 + ((int)blockIdx.x >> 2));
          EpiF32 E{wsp<float>(F, WS_SLAB) + (size_t)kp * MT * DM, DM};
          pg8::gemm_phase<EpiF32, OneOrder, true, true>(ring, gm, S, E);
          if (kp == 0 && F.tid == 0) ctl[CW_FLAG6 + S.u.pm * 8 + S.u.pn] = 1u; }
    } SEAM(6);
    if (IN(7)) { REP(10) norm1(F); } SEAM(7);
    if (IN(8)) {
        constexpr int NGU = 2 * DFF;
        pg8::Gemm gm{wsp<bf16>(F, WS_XN), wsp<bf16>(F, WS_WG), MT, NGU, DM, DM}; RepOrder S; S.init(MT, NGU, F.G, (int)blockIdx.x, RN(11));
        EpiAct E{F.ws, F.out, inp(F, I_DWW), inp(F, I_DWB), inp(F, I_FCONV), (LAS float*)(F.lds + LUT_OFF)};
        pg8::gemm_phase<EpiAct, RepOrder, true, true>(ring, gm, S, E);
        if (F.G == 256) { if (blockIdx.x >= 12) win_copy(F, (int)blockIdx.x - 12, 244, RN(16)); } else win_copy(F, F.vcu, F.G, RN(16));
    } SEAM(8);
    STAMP(10); STAMP(11);
    if (IN(11)) {
        { pg8::Gemm gm{wsp<bf16>(F, WS_ACT), wsp<bf16>(F, WS_WD), MT, DM, DFFP, DFFP}; RepOrder S; S.init(MT, DM, F.G, (int)blockIdx.x, RN(13)); if (F.G == 256) S.maxi = 1;
          EpiBf16P E{wsp<bf16>(F, WS_FFN), DM};
          { pg8::Unit uf; for (int i = 0; S.next(i, uf); ++i) act_fixup(F, uf.pm); }
          pg8::gemm_phase<EpiBf16P, RepOrder, true, true>(ring, gm, S, E); }
        if (F.G == 256 && blockIdx.x < 128) { const int kp = blockIdx.x & 3;
          pg8::Gemm gm{wsp<bf16>(F, WS_ACT) + kp * (DFFP / 4), wsp<bf16>(F, WS_WD) + kp * (DFFP / 4), MT, DM, DFFP, DFFP / 4}; OneOrder S; S.init(MT, DM, F.G, 256 + ((int)blockIdx.x >> 2));
          EpiF32 E{wsp<float>(F, WS_SLAB) + (size_t)kp * MT * DM, DM};
          if (S.ok) act_fixup(F, S.u.pm);
          pg8::gemm_phase<EpiF32, OneOrder, true, true>(ring, gm, S, E);
          if (kp == 0 && F.tid == 0) ctl[CW_FLAG10 + S.u.pm * 8 + S.u.pn] = 1u; }
    } SEAM(11);
    if (IN(12)) { REP(14) norm2(F); }
#if BWPROBE > 0
    __syncthreads(); bw_probe(F);
#endif
#if PROBE_PH >= 0
    STAMP(13);
    if (blockIdx.x == 0) { __syncthreads(); if (F.tid == 0) { const unsigned long long d = (PROBE_PH == 99 ? (stamps[13] - stamps[0]) : (stamps[(PROBE_PH == 99 ? 0 : PROBE_PH) + 1] - stamps[PROBE_PH == 99 ? 0 : PROBE_PH])) * PROBE_AMP, t0 = __builtin_amdgcn_s_memrealtime(); while (__builtin_amdgcn_s_memrealtime() - t0 < d) __builtin_amdgcn_s_sleep(32); } __syncthreads(); }
#endif
#undef REP
#undef RN
#undef IN
#undef SEAM
}

extern "C" void kernel_launch(void* const* d_in, const int* in_sizes, int n_in, void* d_out, int out_size, void* d_ws, size_t ws_size, hipStream_t stream) {
    static int grid = 0;
    if (grid == 0) {
        if (n_in != N_IN || (size_t)out_size != O_END || ws_size < WS_END) { fprintf(stderr, "kernel_launch: unexpected shapes (n_in %d, out %d, ws %zu)\n", n_in, out_size, ws_size); grid = -1; return; }
        int dev = 0, cus = 0;
        if (hipGetDevice(&dev) != hipSuccess || hipDeviceGetAttribute(&cus, hipDeviceAttributeMultiprocessorCount, dev) != hipSuccess) { grid = -1; return; }
        if (hipFuncSetAttribute((const void*)hybrid_fwd, hipFuncAttributeMaxDynamicSharedMemorySize, LDS_BYTES) != hipSuccess) { fprintf(stderr, "kernel_launch: hipFuncSetAttribute failed\n"); grid = -1; return; }
        int per_cu = 0;
        if (hipOccupancyMaxActiveBlocksPerMultiprocessor(&per_cu, (const void*)hybrid_fwd, NTHR, LDS_BYTES) != hipSuccess || per_cu < 1) fprintf(stderr, "kernel_launch: occupancy query says %d\n", per_cu);
        (void)hipGetLastError();
        grid = cus;
    }
    if (grid < 0) return;
    (void)hipMemsetAsync((char*)d_ws + WS_CTL, 0, CTL_ZERO_BYTES, stream);
    Args a{};
    for (int i = 0; i < N_IN; ++i) a.in[i] = d_in[i];
    a.out = (float*)d_out; a.ws = (unsigned char*)d_ws;
#if MK_ONE_LAUNCH
    a.ph_lo = 0; a.ph_hi = N_PHASES;
    hipLaunchKernelGGL(hybrid_fwd, dim3(grid), dim3(NTHR), LDS_BYTES, stream, a);
#else
    for (int p = 0; p < N_PHASES; ++p) { a.ph_lo = p; a.ph_hi = p + 1; hipLaunchKernelGGL(hybrid_fwd, dim3(grid), dim3(NTHR), LDS_BYTES, stream, a); }
#endif
}
```

```cpp
#include <hip/hip_runtime.h>
#include <cstdio>
#include <cstdint>
#ifndef MK_ONE_LAUNCH
#define MK_ONE_LAUNCH 1
#endif
#define DBL_DEFAULT 0
#ifndef DBL
#define DBL DBL_DEFAULT
#endif
#define PROBE_PH_DEFAULT -1
#ifndef PROBE_PH
#define PROBE_PH PROBE_PH_DEFAULT
#endif
#ifndef PROBE_AMP
#define PROBE_AMP 1
#endif
#define BWPROBE 0
namespace pg8 {
#define PG8_LAS __attribute__((address_space(3)))
typedef unsigned short bf16_t;
typedef short bf16x8 __attribute__((ext_vector_type(8)));
typedef float f32x4 __attribute__((ext_vector_type(4)));
typedef unsigned u32x4 __attribute__((ext_vector_type(4)));
constexpr int BM = 256, BK = 64, HALF = 128, HTB = HALF * BK * 2  , STAGE_BYTES = 8 * HTB, NXCD = 8, WGM = 8;

__host__ __device__ __forceinline__ int lds_byte(int r, int c) { const int st = (r >> 4) * 2 + (c >> 5), rr = r & 15, cc = c & 31, ob = rr * 64 + cc * 2; return st * 1024 + (ob ^ (((ob >> 9) & 1) << 5)); }
__host__ __device__ __forceinline__ void stage_rc(int b, int& R, int& C) { const int st = b / 1024, sb = b % 1024, swz = sb ^ (((sb >> 9) & 1) << 5); R = (st >> 1) * 16 + swz / 64; C = (st & 1) * 32 + (swz % 64) / 2; }
__host__ __device__ __forceinline__ int perm32(int rho) { const int n = rho >> 4, i = rho & 15; return 8 * (i >> 2) + 4 * n + (i & 3); }

struct Unit { int pm, pn; };
struct Gemm { const bf16_t* A; const bf16_t* Bt; int M, N, K, Kl; };

struct StaticOrder {
    int nM, nN, nwg, G, c;
    __host__ __device__ __forceinline__ void init(int M, int N, int G_, int c_) { nM = M / BM; nN = N / BM; nwg = nM * nN; G = G_; c = c_; }
    __host__ __device__ __forceinline__ bool next(int i, Unit& u) const {
        const long L = (long)i * G + c; if (L >= nwg) return false;
        int wgid = (int)L; { const int q = nwg / NXCD, r = nwg % NXCD, xcd = wgid % NXCD, off = wgid / NXCD; wgid = (xcd < r ? xcd * (q + 1) : r * (q + 1) + (xcd - r) * q) + off; }
        const int nig = WGM * nN, gid = wgid / nig, fm = gid * WGM, gsz = (nM - fm) < WGM ? (nM - fm) : WGM;
        u.pm = fm + ((wgid % nig) % gsz); u.pn = (wgid % nig) / gsz; return true;
    }
    __device__ __forceinline__ void a_ready(const Unit&) const {}
    __device__ __forceinline__ void done(const Unit&) const {}
};

template <class Epi, class Sched, bool ALIGN_EPI = false, bool SP2 = false>
__device__ __forceinline__ void gemm_phase(PG8_LAS unsigned char* lds, const Gemm g, const Sched& S, const Epi& E) {
    const int tid = threadIdx.x, wid = __builtin_amdgcn_readfirstlane(tid >> 6), lane = tid & 63, wr = wid >> 2, wc = wid & 3, fr = lane & 15, fq = lane >> 4;
    const int K = g.K, nt = g.Kl / BK;
    unsigned voffA[2], voffB[2];
#pragma unroll
    for (int i = 0; i < 2; ++i) { int R, C; stage_rc(tid * 16 + i * 8192, R, C); const int Rb = Epi::PERM ? ((R & ~31) + perm32(R & 31)) : R;
        voffA[i] = (unsigned)(R * K + C) * 2u; voffB[i] = (unsigned)(Rb * K + C) * 2u; }
    const size_t kstep = (size_t)(BK * 2);
    const size_t hstep = (size_t)HALF * K * 2;
    const size_t tstep = 2 * hstep;
    const unsigned ldsw = (unsigned)wid * 1024u;
    const int aoff = lds_byte(wr * 64 + fr, fq * 8), boff = lds_byte(wc * 32 + fr, fq * 8);
#define PG8_SA(b, h) (((b) * 2 + (h)) * HTB)
#define PG8_SB(b, h) ((4 + (b) * 2 + (h)) * HTB)
#define PG8_STAGE(bufoff, gbase, voff) do { _Pragma("unroll") for (int _i = 0; _i < 2; ++_i) \
        __builtin_amdgcn_global_load_lds((const unsigned*)((const char*)(gbase) + (voff)[_i]), (PG8_LAS unsigned*)(lds + (bufoff) + ldsw + _i * 8192), 16, 0, 0); } while (0)
#define PG8_LDA(dst, b, h) do { _Pragma("unroll") for (int m = 0; m < 4; ++m) _Pragma("unroll") for (int k = 0; k < 2; ++k) dst[m][k] = *(const PG8_LAS bf16x8*)(lds + PG8_SA(b, h) + aoff + m * 2048 + k * 1024); } while (0)
#define PG8_LDB(dst, b, h) do { _Pragma("unroll") for (int n = 0; n < 2; ++n) _Pragma("unroll") for (int k = 0; k < 2; ++k) dst[n][k] = *(const PG8_LAS bf16x8*)(lds + PG8_SB(b, h) + boff + n * 2048 + k * 1024); } while (0)
#define PG8_MMA(ai, bj, At, Bt) do { __builtin_amdgcn_s_setprio(1); _Pragma("unroll") for (int m = 0; m < 4; ++m) _Pragma("unroll") for (int n = 0; n < 2; ++n) _Pragma("unroll") for (int k = 0; k < 2; ++k) \
        acc[ai][bj][m][n] = __builtin_amdgcn_mfma_f32_16x16x32_bf16(Bt[n][k], At[m][k], acc[ai][bj][m][n], 0, 0, 0); __builtin_amdgcn_s_setprio(0); } while (0)
#define PG8_WAIT_V(n) asm volatile("s_waitcnt vmcnt(" #n ")" ::: "memory")
#define PG8_WAIT_L(n) asm volatile("s_waitcnt lgkmcnt(" #n ")" ::: "memory")
#define PG8_BAR __builtin_amdgcn_s_barrier()
#define PG8_SCHED __builtin_amdgcn_sched_barrier(0)
    Unit cur, nxt; int ui = 0;
    if (!S.next(0, cur)) return;
    f32x4 acc[2][2][4][2];
#pragma unroll
    for (int a = 0; a < 2; ++a)
#pragma unroll
        for (int b = 0; b < 2; ++b)
#pragma unroll
            for (int m = 0; m < 4; ++m)
#pragma unroll
                for (int n = 0; n < 2; ++n) acc[a][b][m][n] = (f32x4){0.f, 0.f, 0.f, 0.f};
    bf16x8 At[4][2], B0[2][2], B1[2][2];
    const char* cA = (const char*)g.A + (size_t)cur.pm * tstep; const char* cB = (const char*)g.Bt + (size_t)cur.pn * tstep;
    S.a_ready(cur);
    if constexpr (SP2) {
        PG8_STAGE(PG8_SB(0, 0), cB, voffB); PG8_STAGE(PG8_SB(0, 1), cB + hstep, voffB); PG8_STAGE(PG8_SA(0, 0), cA, voffA); PG8_STAGE(PG8_SA(0, 1), cA + hstep, voffA);
        if (wr == 1) PG8_BAR;
        PG8_WAIT_V(2); PG8_BAR;
        PG8_STAGE(PG8_SB(1, 0), cB + kstep, voffB); PG8_STAGE(PG8_SA(1, 0), cA + kstep, voffA); PG8_STAGE(PG8_SB(1, 1), cB + hstep + kstep, voffB);
        PG8_WAIT_V(6); PG8_BAR;
    } else {
        PG8_STAGE(PG8_SB(0, 0), cB, voffB); PG8_STAGE(PG8_SA(0, 0), cA, voffA); PG8_STAGE(PG8_SB(0, 1), cB + hstep, voffB); PG8_STAGE(PG8_SA(0, 1), cA + hstep, voffA);
        if (wr == 1) PG8_BAR;
        PG8_WAIT_V(4); PG8_BAR;
        PG8_STAGE(PG8_SB(1, 0), cB + kstep, voffB); PG8_STAGE(PG8_SA(1, 0), cA + kstep, voffA); PG8_STAGE(PG8_SB(1, 1), cB + hstep + kstep, voffB);
        PG8_WAIT_V(6); PG8_BAR;
    }
    for (;;) {
        const bool has_next = S.next(ui + 1, nxt);
        const char* nA = has_next ? (const char*)g.A + (size_t)nxt.pm * tstep : cA; const char* nB = has_next ? (const char*)g.Bt + (size_t)nxt.pn * tstep : cB;
        for (int t = 0; t < nt; t += 2) {
            const bool last = (t == nt - 2);
            const char* a1 = cA + (size_t)(t + 1) * kstep;
            const char* a2 = last ? nA : cA + (size_t)(t + 2) * kstep; const char* b2 = last ? nB : cB + (size_t)(t + 2) * kstep;
            const char* a3 = a2 + kstep; const char* b3 = b2 + kstep;
            if (last && has_next) S.a_ready(nxt);
            if constexpr (SP2) {
            PG8_LDB(B0, 0, 0); PG8_LDB(B1, 0, 1); PG8_SCHED; PG8_LDA(At, 0, 0); PG8_STAGE(PG8_SA(1, 1), a1 + hstep, voffA);
            PG8_WAIT_V(8); PG8_WAIT_L(0); PG8_BAR; PG8_MMA(0, 0, At, B0); PG8_MMA(0, 1, At, B1); PG8_BAR; PG8_SCHED;
            PG8_LDA(At, 0, 1); PG8_STAGE(PG8_SB(0, 0), b2, voffB); PG8_STAGE(PG8_SB(0, 1), b2 + hstep, voffB); PG8_STAGE(PG8_SA(0, 0), a2, voffA);
            PG8_WAIT_V(8); PG8_WAIT_L(0); PG8_BAR; PG8_MMA(1, 0, At, B0); PG8_MMA(1, 1, At, B1); PG8_BAR; PG8_SCHED;
            PG8_LDB(B0, 1, 0); PG8_LDB(B1, 1, 1); PG8_SCHED; PG8_LDA(At, 1, 0); PG8_STAGE(PG8_SA(0, 1), a2 + hstep, voffA);
            PG8_WAIT_V(8); PG8_WAIT_L(0); PG8_BAR; PG8_MMA(0, 0, At, B0); PG8_MMA(0, 1, At, B1); PG8_BAR; PG8_SCHED;
            PG8_LDA(At, 1, 1); PG8_STAGE(PG8_SB(1, 0), b3, voffB); PG8_STAGE(PG8_SB(1, 1), b3 + hstep, voffB); PG8_STAGE(PG8_SA(1, 0), a3, voffA);
            PG8_WAIT_V(8); PG8_WAIT_L(0); PG8_BAR; PG8_MMA(1, 0, At, B0); PG8_MMA(1, 1, At, B1); PG8_BAR; PG8_SCHED;
            } else {
            PG8_LDB(B0, 0, 0); PG8_SCHED; PG8_LDA(At, 0, 0); PG8_STAGE(PG8_SA(1, 1), a1 + hstep, voffA);
            PG8_WAIT_L(8); PG8_BAR; PG8_WAIT_L(0); PG8_MMA(0, 0, At, B0); PG8_BAR; PG8_SCHED;
            PG8_LDB(B1, 0, 1); PG8_STAGE(PG8_SB(0, 0), b2, voffB);
            PG8_BAR; PG8_WAIT_L(0); PG8_MMA(0, 1, At, B1); PG8_BAR;
            PG8_LDA(At, 0, 1); PG8_STAGE(PG8_SA(0, 0), a2, voffA);
            PG8_BAR; PG8_WAIT_L(0); PG8_MMA(1, 0, At, B0); PG8_BAR; PG8_SCHED;
            PG8_STAGE(PG8_SB(0, 1), b2 + hstep, voffB);
            PG8_WAIT_V(6); PG8_BAR; PG8_MMA(1, 1, At, B1); PG8_BAR;
            PG8_LDB(B0, 1, 0); PG8_SCHED; PG8_LDA(At, 1, 0); PG8_STAGE(PG8_SA(0, 1), a2 + hstep, voffA);
            PG8_WAIT_L(8); PG8_BAR; PG8_WAIT_L(0); PG8_MMA(0, 0, At, B0); PG8_BAR; PG8_SCHED;
            PG8_LDB(B1, 1, 1); PG8_STAGE(PG8_SB(1, 0), b3, voffB);
            PG8_BAR; PG8_WAIT_L(0); PG8_MMA(0, 1, At, B1); PG8_BAR;
            PG8_LDA(At, 1, 1); PG8_STAGE(PG8_SA(1, 0), a3, voffA);
            PG8_BAR; PG8_WAIT_L(0); PG8_MMA(1, 0, At, B0); PG8_BAR; PG8_SCHED;
            PG8_STAGE(PG8_SB(1, 1), b3 + hstep, voffB);
            PG8_WAIT_V(6); PG8_BAR; PG8_MMA(1, 1, At, B1); PG8_BAR;
            }
        }
        if constexpr (ALIGN_EPI) { if (wr == 0) PG8_BAR; }
        if constexpr (!Epi::AFTER_DRAIN) { E(acc, cur, wr, wc, fr, fq); S.done(cur); }
        if (!has_next) break;
#pragma unroll
        for (int a = 0; a < 2; ++a)
#pragma unroll
            for (int b = 0; b < 2; ++b)
#pragma unroll
                for (int m = 0; m < 4; ++m)
#pragma unroll
                    for (int n = 0; n < 2; ++n) acc[a][b][m][n] = (f32x4){0.f, 0.f, 0.f, 0.f};
        cur = nxt; cA = nA; cB = nB; ++ui;
        if constexpr (ALIGN_EPI) { if (wr == 1) PG8_BAR; }
    }
    PG8_WAIT_V(0);
    if constexpr (!ALIGN_EPI) { if (wr == 0) PG8_BAR; }
    PG8_BAR;
    if constexpr (Epi::AFTER_DRAIN) { E.fused(acc, cur, wr, wc, fr, fq, lds, wid, lane); S.done(cur); }
#undef PG8_SA
#undef PG8_SB
#undef PG8_STAGE
#undef PG8_LDA
#undef PG8_LDB
#undef PG8_MMA
#undef PG8_WAIT_V
#undef PG8_WAIT_L
#undef PG8_BAR
#undef PG8_SCHED
}
}

#define LAS __attribute__((address_space(3)))
#define DI __device__ __forceinline__
typedef unsigned short bf16;
typedef short bf16x8 __attribute__((ext_vector_type(8)));
typedef short s16x4 __attribute__((ext_vector_type(4)));
typedef float f32x4 __attribute__((ext_vector_type(4)));
typedef float f32x2 __attribute__((ext_vector_type(2)));
typedef float f32x16 __attribute__((ext_vector_type(16)));
typedef unsigned u32x4 __attribute__((ext_vector_type(4)));
typedef unsigned u32x2 __attribute__((ext_vector_type(2)));
typedef __bf16 bf16x2_t __attribute__((ext_vector_type(2)));

constexpr int NWAVES = 8, NTHR = 512;
constexpr int DM = 2048, BP = 4, TP = 2048, BS = 128, TS = 8, MP = BP * TP, MS = BS * TS, MT = MP + MS;
constexpr int NPROJ = 5888, DFF = 5504, DFFP = 5632, INW = 5696;
constexpr int NUNIT = 16 + 512;
constexpr float EPS = 1e-6f, NEGF = -1e30f, TINYF = 1e-30f;
enum { I_XP = 0, I_XS, I_CKV, I_CWIN, I_SCONV, I_SSM, I_FCONV, I_PT, I_REL, I_LNPRE, I_WIN, I_CPE, I_CW1, I_CB1, I_CW2, I_CB2, I_SCW, I_SCB, I_DTB, I_ALOG, I_SD, I_SNG,
       I_WOUT, I_LNPOST, I_LNFPRE, I_WG, I_WU, I_DWW, I_DWB, I_WD, I_LNFPOST, N_IN };
constexpr size_t O_YP = 0, O_YS = 16777216, O_KVP = 18874368, O_KVS = 27262976, O_WINP = 28311552, O_WINS = 29360128, O_SCP = 62914560, O_SCS = 62939136,
                 O_SSP = 63725568, O_SSS = 64249856, O_FCP = 81027072, O_FCS = 81071104, O_END = 82480128;
constexpr size_t MiB = 1u << 20;
constexpr size_t WS_CTL = 0, CTL_ZERO_BYTES = 1 * MiB;
constexpr size_t WS_WIN = 2 * MiB, WS_WOUT = 26 * MiB, WS_WG = 34 * MiB, WS_WU = 56 * MiB, WS_WD = 78 * MiB, WS_W12 = 100 * MiB;
constexpr size_t WS_W2T = 101 * MiB, WS_CBP = 101 * MiB + 65536, WS_LUT = 101 * MiB + 131072;
constexpr size_t WS_XN = 102 * MiB, WS_QB = 138 * MiB, WS_KB = 156 * MiB, WS_VT = 164 * MiB, WS_ZF = 172 * MiB, WS_XBC = 208 * MiB;
constexpr size_t WS_GATE = 280 * MiB, WS_DTR = 282 * MiB, WS_XBCC = 284 * MiB, WS_DT = 356 * MiB, WS_KCK = 358 * MiB, WS_KCVT = 368 * MiB;
constexpr size_t WS_YSSM = 378 * MiB, WS_MIX = 414 * MiB, WS_MIXO = 450 * MiB, WS_X1 = 522 * MiB, WS_GP = 594 * MiB, WS_ACT = 694 * MiB, WS_FFN = 794 * MiB, WS_SC = 868 * MiB, WS_HPREV = 900 * MiB, WS_ACUM = 916 * MiB, WS_ATOT = 917 * MiB, WS_SLAB = 918 * MiB, WS_UP = 1206 * MiB, WS_HALO = 1306 * MiB, WS_FIXG = 1308 * MiB, WS_FIXU = 1310 * MiB, WS_END = 1312 * MiB;
constexpr int CW_BAR = 4096, CW_FLAG6 = 8192, CW_FLAG10 = 8192 + 512;
constexpr int RING_BYTES = 131072, LDSCTL_OFF = RING_BYTES, MISC_OFF = LDSCTL_OFF + 320, PTAB_OFF = RING_BYTES + 512, LUT_OFF = RING_BYTES + 1024, LDS_BYTES = 147456;
static_assert(LUT_OFF + 8192 <= LDS_BYTES, "LDS map");

DI unsigned pk2(float lo, float hi) { f32x2 v = {lo, hi}; bf16x2_t b = __builtin_convertvector(v, bf16x2_t); return __builtin_bit_cast(unsigned, b); }
DI bf16x8 cvt8(f32x4 a, f32x4 b) { u32x4 p = {pk2(a.x, a.y), pk2(a.z, a.w), pk2(b.x, b.y), pk2(b.z, b.w)}; return __builtin_bit_cast(bf16x8, p); }
DI float bf2f(unsigned short u) { return __uint_as_float(((unsigned)u) << 16); }
DI float sigmoidf_(float x) { return __builtin_amdgcn_rcpf(1.0f + __builtin_amdgcn_exp2f(-1.4426950408889634f * x)); }
DI float siluf_(float x) { return x * sigmoidf_(x); }
DI float gelu_tanh(float x) { const float u2 = (-2.0f * 0.7978845608028654f * 1.4426950408889634f) * (x + 0.044715f * x * x * x); return x * __builtin_amdgcn_rcpf(1.0f + __builtin_amdgcn_exp2f(u2)); }
DI float softplusf_(float x) { return x > 20.f ? x : log1pf(__expf(x)); }
DI int crow(int reg, int h) { return (reg & 3) + 8 * (reg >> 2) + 4 * h; }
DI float wave_sum(float v) {
#pragma unroll
    for (int o = 1; o < 64; o <<= 1) v += __shfl_xor(v, o);
    return v;
}
#define MFMA32(a, b, c) __builtin_amdgcn_mfma_f32_32x32x16_bf16((a), (b), (c), 0, 0, 0)
#define VM_WAIT() asm volatile("s_waitcnt vmcnt(0)" ::: "memory")
#define LDS_WAIT() asm volatile("s_waitcnt lgkmcnt(0)" ::: "memory")

struct Frame {
    LAS unsigned char* lds;
    int tid, lane, wave, vcu, G;
    LAS unsigned* ptab; const int* pt;
    float* out; unsigned char* ws;
};
template <class T> DI T* wsp(const Frame& F, size_t off) { return (T*)(F.ws + off); }
DI const float* inp(const Frame& F, int k) { const unsigned lo = __builtin_amdgcn_readfirstlane(F.ptab[2 * k]), hi = __builtin_amdgcn_readfirstlane(F.ptab[2 * k + 1]); const __attribute__((address_space(1))) float* gp = (const __attribute__((address_space(1))) float*)(((unsigned long long)hi << 32) | lo); return (const float*)gp; }

template <int MAP> DI int rowmap(int n) {
    if (MAP == 0) return n;
    if (MAP == 2) return 256 * (n >> 7) + (n & 127);
    if (MAP == 3) return 256 * (n >> 7) + 128 + (n & 127);
    if (n < 2560) return n;
    if (n < 2608) return 5632 + (n - 2560);
    if (n < 3632) return 2560 + (n - 2608);
    if (n < 5680) return 3584 + (n - 3632);
    return 5632 + 48 + (n - 5680);
}
template <int MAP> DI void transpose_item(const float* W, int N, bf16* WT, int dst_pitch, int row_off, LAS float* scr, int item, int lane) {
    const int nblk = N / 32, kb = item / nblk, nb = item % nblk, k0 = 64 * kb, n0 = 32 * nb;
    float wv[32];
#pragma unroll
    for (int i = 0; i < 32; ++i) wv[i] = W[(size_t)(k0 + 2 * i + (lane >> 5)) * N + n0 + (lane & 31)];
#pragma unroll
    for (int i = 0; i < 32; ++i) scr[(2 * i + (lane >> 5)) * 33 + (lane & 31)] = wv[i];
    LDS_WAIT(); asm volatile("" ::: "memory");
    const int c = lane & 7;
#pragma unroll
    for (int j = 0; j < 4; ++j) { const int n = (lane >> 3) + 8 * j; const LAS float* s = scr + (8 * c) * 33 + n;
        u32x4 o; o.x = pk2(s[0 * 33], s[1 * 33]); o.y = pk2(s[2 * 33], s[3 * 33]); o.z = pk2(s[4 * 33], s[5 * 33]); o.w = pk2(s[6 * 33], s[7 * 33]);
        if (MAP == 4) { const int nn = row_off + n0 + n, kk = k0 + 8 * c;
            *(u32x4*)(WT + ((size_t)(((nn >> 5) * (dst_pitch >> 4) + (kk >> 4)) * 64 + ((kk >> 3) & 1) * 32 + (nn & 31))) * 8) = o; }
        else *(u32x4*)(WT + (size_t)(row_off + rowmap<MAP>(n0 + n)) * dst_pitch + k0 + 8 * c) = o; }
    LDS_WAIT(); asm volatile("" ::: "memory");
}
DI void rmsnorm_row_bf16(const float* xrow, const float* g, bf16* orow, int lane) {
    const f32x4* xr = (const f32x4*)xrow + lane; const f32x4* gr = (const f32x4*)g + lane;
    f32x4 v[8]; float s = 0.f;
#pragma unroll
    for (int j = 0; j < 8; ++j) { v[j] = xr[64 * j]; s += (v[j].x * v[j].x + v[j].y * v[j].y) + (v[j].z * v[j].z + v[j].w * v[j].w); }
    const float rs = 1.0f / sqrtf(wave_sum(s) * (1.f / DM) + EPS);
    u32x2* o8 = (u32x2*)orow + lane;
#pragma unroll
    for (int j = 0; j < 8; ++j) { const f32x4 gg = gr[64 * j]; u32x2 w; w.x = pk2(v[j].x * rs * gg.x, v[j].y * rs * gg.y); w.y = pk2(v[j].z * rs * gg.z, v[j].w * rs * gg.w); o8[64 * j] = w; }
}
DI int rel_bucket(int n) {
    if (n < 16) return n;
    const int v = 16 + (int)(logf((float)n * (1.0f / 16.0f)) * (16.0f / 2.0794415416798357f));
    return v < 31 ? v : 31;
}
DI void win_copy(Frame& F, int rank, int nranks, int Rc) {
    const f32x4* src = (const f32x4*)inp(F, I_CWIN); f32x4* dst = (f32x4*)(F.out + O_WINS);
    for (int ii = rank * NTHR + F.tid; ii < BS * 504 * 128 * Rc; ii += nranks * NTHR) { const int i = ii % (BS * 504 * 128); const int b = i / (504 * 128), rr = i % (504 * 128); dst[(size_t)b * 512 * 128 + rr] = src[(size_t)b * 512 * 128 + 8 * 128 + rr]; }
}
DI void wd_convert_tail(Frame& F, int rank, int nranks) {
    LAS float* scr = (LAS float*)(F.lds + F.wave * 16384); bf16* WDT = wsp<bf16>(F, WS_WD);
    constexpr int I_D = (DFF / 64) * (DM / 32);
    __syncthreads();
    for (int it = rank * NWAVES + F.wave; it < I_D; it += nranks * NWAVES) transpose_item<0>(inp(F, I_WD), DM, WDT, DFFP, 0, scr, it, F.lane);
}
DI void ph0_prologue(Frame& F, int Ra, int Rc, int Re) {
    LAS float* scr = (LAS float*)(F.lds + F.wave * 16384);
    const int gw = F.vcu * NWAVES + F.wave, NGW = F.G * NWAVES, lane = F.lane;
    bf16* WINT = wsp<bf16>(F, WS_WIN); bf16* WOUTT = wsp<bf16>(F, WS_WOUT); bf16* WGT = wsp<bf16>(F, WS_WG); bf16* WUT = wsp<bf16>(F, WS_WU); bf16* WDT = wsp<bf16>(F, WS_WD);
    bf16* W12T = wsp<bf16>(F, WS_W12); bf16* W2T = wsp<bf16>(F, WS_W2T);
    constexpr int I_IN = (DM / 64) * (INW / 32), I_OUT = (DM / 64) * (DM / 32), I_G = (DM / 64) * (DFF / 32), I_D = (DFF / 64) * (DM / 32), I_12 = (1024 / 64) * (128 / 32), I_2 = (128 / 64) * (64 / 32);
    const bool skip_d = F.G == 256; const int NITEMS = I_IN + I_OUT + 2 * I_G + (skip_d ? 0 : I_D) + 4 * I_12 + 2 * I_2;
    for (int it = gw; it < NITEMS * Ra; it += NGW) {
        int r = it % NITEMS;
        if (r < I_IN) { transpose_item<1>(inp(F, I_WIN), INW, WINT, DM, 0, scr, r, lane); continue; } r -= I_IN;
        if (r < I_OUT) { transpose_item<0>(inp(F, I_WOUT), DM, WOUTT, DM, 0, scr, r, lane); continue; } r -= I_OUT;
        if (r < I_G) { transpose_item<2>(inp(F, I_WG), DFF, WGT, DM, 0, scr, r, lane); continue; } r -= I_G;
        if (r < I_G) { transpose_item<3>(inp(F, I_WU), DFF, WGT, DM, 0, scr, r, lane); continue; } r -= I_G;
        if (!skip_d) { if (r < I_D) { transpose_item<0>(inp(F, I_WD), DM, WDT, DFFP, 0, scr, r, lane); continue; } r -= I_D; }
        if (r < 4 * I_12) { const int q = r / I_12, kv = q >> 1, hf = q & 1;
            transpose_item<4>(inp(F, I_CW1) + (size_t)kv * 2048 * 128 + (size_t)hf * 1024 * 128, 128, W12T + (size_t)kv * 256 * 1024, 1024, hf * 128, scr, r % I_12, lane); continue; } r -= 4 * I_12;
        { const int kv = r / I_2; transpose_item<0>(inp(F, I_CW2) + (size_t)kv * 128 * 64, 64, W2T + (size_t)kv * 64 * 128, 128, 0, scr, r % I_2, lane); }
    }
    {
        const int gt = F.vcu * NTHR + F.tid, NGT = F.G * NTHR; const u32x4 z = {0u, 0u, 0u, 0u};
        for (int i = gt; i < 192 * 256; i += NGT) ((u32x4*)(WINT + (size_t)5696 * DM))[i] = z;
        for (int i = gt; i < 256 * 256; i += NGT) ((u32x4*)(WGT + (size_t)(2 * DFF) * DM))[i] = z;
        for (int i = gt; i < 2048 * 16; i += NGT) { const int row = i >> 4, c = i & 15; *(u32x4*)(WDT + (size_t)row * DFFP + DFF + 8 * c) = z; }
        { bf16* ACT = wsp<bf16>(F, WS_ACT); for (int i = gt; i < MT * 16; i += NGT) { const int row = i >> 4, c = i & 15; *(u32x4*)(ACT + (size_t)row * DFFP + DFF + 8 * c) = z; } }
        float* LUT = wsp<float>(F, WS_LUT);
        for (int i = gt; i < 2048; i += NGT) { const int dist = i >> 4, hd = i & 15; LUT[i] = inp(F, I_REL)[rel_bucket(dist) * 16 + hd]; }
    }
    {
        float* CBP = wsp<float>(F, WS_CBP); LAS float* red = (LAS float*)(F.lds + 12288);
        for (int it = F.vcu; it < 32; it += F.G) { const int kv = it >> 4, part = (it >> 1) & 7, hh = (it & 1) * 64 + lane;
            const float* pe = inp(F, I_CPE) + (size_t)kv * 2048; const float* w1 = inp(F, I_CW1) + (size_t)kv * 2048 * 128; float s = 0.f;
            const int k0 = part * 256 + F.wave * 32;
#pragma unroll
            for (int k = 0; k < 32; ++k) s += pe[k0 + k] * w1[(size_t)(k0 + k) * 128 + hh];
            red[F.wave * 64 + lane] = s;
            __syncthreads();
            if (F.wave == 0) { float t = 0.f;
#pragma unroll
                for (int w2 = 0; w2 < 8; ++w2) t += red[w2 * 64 + lane];
                CBP[(kv * 8 + part) * 128 + hh] = t; }
            __syncthreads(); }
    }
    bf16* XN = wsp<bf16>(F, WS_XN);
    for (int mm = gw; mm < MT * Re; mm += NGW) { const int m = mm % MT; const float* xr = m < MP ? inp(F, I_XP) + (size_t)m * DM : inp(F, I_XS) + (size_t)(m - MP) * DM; rmsnorm_row_bf16(xr, inp(F, I_LNPRE), XN + (size_t)m * DM, lane); }
}
#define XB_TMO      128
#define XB_XCNT(j)  (256  + 64 * (j))
#define XB_XSUB(j)  (1280 + 64 * (j))
#define XB_XGEN(j)  (2304 + 64 * (j))
#define XB_TOP      3328
#define XB_TOPGEN   3392
#define XCD_BAR_WORDS 3456
#define XB_SPIN_CAP (1u << 18)

__device__ __forceinline__ unsigned xb_ld(unsigned* p)              { return __hip_atomic_load(p, __ATOMIC_RELAXED, __HIP_MEMORY_SCOPE_AGENT); }
__device__ __forceinline__ unsigned xb_add(unsigned* p, unsigned v) { return __hip_atomic_fetch_add(p, v, __ATOMIC_RELAXED, __HIP_MEMORY_SCOPE_AGENT); }
__device__ __forceinline__ unsigned xb_xcc_id() { return (unsigned)__builtin_amdgcn_s_getreg((3 << 11) | 20) & 0xFu; }
#define XB_SPIN(cond, bar) do { unsigned _sp = 0; while (cond) { __builtin_amdgcn_s_sleep(1); \
    if ((++_sp & 255u) == 0u) { if (xb_ld(&(bar)[XB_TMO])) break; if (_sp > XB_SPIN_CAP) { atomicAdd(&(bar)[XB_TMO], 1u); break; } } } } while (0)

struct XcdBarrier {
    unsigned* bar; unsigned x;
    volatile LAS unsigned* st;
};

__device__ __forceinline__ XcdBarrier xcd_barrier_post(unsigned* bar, volatile LAS unsigned* st) {
    XcdBarrier b; b.bar = bar; b.x = xb_xcc_id(); b.st = st;
    if (threadIdx.x == 0) (void)xb_add(&bar[XB_XCNT(b.x)], 1u);
    return b;
}
__device__ __forceinline__ void xcd_barrier_complete(unsigned* bar, unsigned x, unsigned& nloc, unsigned& nx) {
    const unsigned G = gridDim.x * gridDim.y * gridDim.z;
    unsigned sum, cnt, mine, sp = 0u;
    for (;;) {
        sum = 0u; cnt = 0u; mine = 0u;
#pragma unroll
        for (unsigned j = 0; j < 16; ++j) { const unsigned c = xb_ld(&bar[XB_XCNT(j)]); sum += c; cnt += (c > 0u) ? 1u : 0u; mine = (j == x) ? c : mine; }
        if (sum == G) break;
        __builtin_amdgcn_s_sleep(1);
        if ((++sp & 255u) == 0u) { if (xb_ld(&bar[XB_TMO])) break; if (sp > XB_SPIN_CAP) { atomicAdd(&bar[XB_TMO], 1u); break; } }
    }
    nloc = mine > 0u ? mine : 1u; nx = cnt > 0u ? cnt : 1u;
}

__device__ __forceinline__ void xcd_barrier(const XcdBarrier& b) {
    asm volatile("s_waitcnt vmcnt(0)" ::: "memory");
    __syncthreads();
    if (threadIdx.x == 0) {
        unsigned* bar = b.bar;
        __builtin_amdgcn_s_waitcnt(0);
        unsigned nloc = b.st[0], nx = b.st[1];
        if (nloc == 0u) { xcd_barrier_complete(bar, b.x, nloc, nx); b.st[0] = nloc; b.st[1] = nx; }
        const unsigned old = xb_add(&bar[XB_XSUB(b.x)], 1u);
        const unsigned gen = old / nloc;
        if (old + 1u == (gen + 1u) * nloc) {
            __builtin_amdgcn_fence(__ATOMIC_RELEASE, "agent");
            asm volatile("s_waitcnt vmcnt(0)" ::: "memory");
            const unsigned og = xb_add(&bar[XB_TOP], 1u);
            const unsigned tg = og / nx;
            if (og + 1u == (tg + 1u) * nx) xb_add(&bar[XB_TOPGEN], 1u);
            else XB_SPIN(xb_ld(&bar[XB_TOPGEN]) == tg, bar);
            __builtin_amdgcn_fence(__ATOMIC_ACQUIRE, "agent");
            xb_add(&bar[XB_XGEN(b.x)], 1u);
            asm volatile("s_waitcnt vmcnt(0)" ::: "memory");
        } else {
            XB_SPIN(xb_ld(&bar[XB_XGEN(b.x)]) == gen, bar);
            __builtin_amdgcn_fence(__ATOMIC_ACQUIRE, "agent");
            asm volatile("s_waitcnt vmcnt(0)" ::: "memory");
        }
    }
    __syncthreads();
}

struct EpiProj {
    static constexpr bool PERM = false, AFTER_DRAIN = false;
    unsigned char* ws; float* out;
    __device__ __forceinline__ void operator()(const pg8::f32x4 (&acc)[2][2][4][2], const pg8::Unit& u, int wr, int wc, int fr, int fq) const {
        const int pn = u.pn;
        bf16* const QB = (bf16*)(ws + WS_QB); bf16* const KB = (bf16*)(ws + WS_KB); bf16* const VT = (bf16*)(ws + WS_VT); float* const ZF = (float*)(ws + WS_ZF); float* const XBC = (float*)(ws + WS_XBC); float* const GATE = (float*)(ws + WS_GATE); float* const DTR = (float*)(ws + WS_DTR);
#pragma unroll
        for (int ai = 0; ai < 2; ++ai)
#pragma unroll
            for (int m = 0; m < 4; ++m) {
                const int row = u.pm * 256 + ai * 128 + wr * 64 + m * 16 + fr;
                const bool isp = row < MP; const int b = isp ? (row >> 11) : ((row - MP) >> 3); const int t = isp ? (row & 2047) : ((row - MP) & 7);
#pragma unroll
                for (int bj = 0; bj < 2; ++bj)
#pragma unroll
                    for (int n = 0; n < 2; ++n) {
                        const int cl = bj * 128 + wc * 32 + n * 16 + fq * 4; const f32x4 v = acc[ai][bj][m][n];
                        if (pn < 4) { u32x2 w; w.x = pk2(v.x, v.y); w.y = pk2(v.z, v.w); *(u32x2*)(QB + (size_t)row * 1024 + pn * 256 + cl) = w; }
                        else if (pn < 10) { const int slot = pn - 4, g = cl >> 6, d = cl & 63;
                            if (slot < 4) { float* dst = isp ? out + O_KVP + ((size_t)row * 4 + slot) * 256 + cl : out + O_KVS + ((size_t)(row - MP) * 4 + slot) * 256 + cl; *(f32x4*)dst = v; }
                            else { const int s2 = slot - 4;
                                if (isp) { if (t >= TP - 512) *(f32x4*)(out + O_WINP + (((size_t)b * 512 + (t - (TP - 512))) * 2 + s2) * 256 + cl) = v; }
                                else *(f32x4*)(out + O_WINS + (((size_t)b * 512 + 504 + t) * 2 + s2) * 256 + cl) = v; }
                            if (isp && slot >= 2) { const int sl = slot >> 2;
                                if ((slot & 1) == 0) { u32x2 w; w.x = pk2(v.x, v.y); w.y = pk2(v.z, v.w); *(u32x2*)(KB + ((size_t)((b * 2 + sl) * 4 + g) * 2048 + t) * 64 + d) = w; }
                                else { bf16* vp = VT + ((size_t)((b * 2 + sl) * 4 + g) * 64 + d) * 2048 + t; const unsigned p0 = pk2(v.x, v.y), p1 = pk2(v.z, v.w);
                                    vp[0] = (bf16)(p0 & 0xffffu); vp[2048] = (bf16)(p0 >> 16); vp[4096] = (bf16)(p1 & 0xffffu); vp[6144] = (bf16)(p1 >> 16); } } }
                        else if (pn < 14) *(f32x4*)(ZF + (size_t)row * 1024 + (pn - 10) * 256 + cl) = v;
                        else if (pn < 22) *(f32x4*)(XBC + (size_t)row * 2048 + (pn - 14) * 256 + cl) = v;
                        else { if (cl < 48) { f32x4 s; s.x = sigmoidf_(v.x); s.y = sigmoidf_(v.y); s.z = sigmoidf_(v.z); s.w = sigmoidf_(v.w); *(f32x4*)(GATE + (size_t)row * 48 + cl) = s; }
                               else if (cl < 64) *(f32x4*)(DTR + (size_t)row * 16 + (cl - 48)) = v; }
                    }
            }
    }
};
struct EpiF32 {
    static constexpr bool PERM = false, AFTER_DRAIN = false;
    float* O; int ldc;
    __device__ __forceinline__ void operator()(const pg8::f32x4 (&acc)[2][2][4][2], const pg8::Unit& u, int wr, int wc, int fr, int fq) const {
#pragma unroll
        for (int ai = 0; ai < 2; ++ai)
#pragma unroll
            for (int m = 0; m < 4; ++m) { float* rowp = O + (size_t)(u.pm * 256 + ai * 128 + wr * 64 + m * 16 + fr) * ldc + u.pn * 256 + wc * 32 + fq * 4;
#pragma unroll
                for (int bj = 0; bj < 2; ++bj)
#pragma unroll
                    for (int n = 0; n < 2; ++n) *(f32x4*)(rowp + bj * 128 + n * 16) = acc[ai][bj][m][n]; }
    }
};
struct EpiBf16P {
    static constexpr bool PERM = true, AFTER_DRAIN = false;
    bf16* O; int ldc;
    __device__ __forceinline__ void operator()(const pg8::f32x4 (&acc)[2][2][4][2], const pg8::Unit& u, int wr, int wc, int fr, int fq) const {
#pragma unroll
        for (int ai = 0; ai < 2; ++ai)
#pragma unroll
            for (int m = 0; m < 4; ++m) { bf16* rowp = O + (size_t)(u.pm * 256 + ai * 128 + wr * 64 + m * 16 + fr) * ldc + u.pn * 256 + wc * 32 + fq * 8;
#pragma unroll
                for (int bj = 0; bj < 2; ++bj) { const f32x4 v0 = acc[ai][bj][m][0], v1 = acc[ai][bj][m][1]; u32x4 w; w.x = pk2(v0.x, v0.y); w.y = pk2(v0.z, v0.w); w.z = pk2(v1.x, v1.y); w.w = pk2(v1.z, v1.w); *(u32x4*)(rowp + bj * 128) = w; } }
    }
};
struct EpiGate {
    static constexpr bool PERM = true, AFTER_DRAIN = false;
    bf16* GP; float* out; bf16* UP;
    __device__ __forceinline__ void operator()(const pg8::f32x4 (&acc)[2][2][4][2], const pg8::Unit& u, int wr, int wc, int fr, int fq) const {
        const bool isup = u.pn >= 22; bf16* const dstm = isup ? UP : GP; const int colt = (isup ? u.pn - 22 : u.pn) * 256 + wc * 32 + 8 * fq;
#pragma unroll
        for (int ai = 0; ai < 2; ++ai)
#pragma unroll
            for (int m = 0; m < 4; ++m) { const int row = u.pm * 256 + ai * 128 + wr * 64 + m * 16 + fr;
                const bool isp = row < MP; const int b = isp ? (row >> 11) : ((row - MP) >> 3); const int t = isp ? (row & 2047) : ((row - MP) & 7);
                const int tl = isp ? t - (TP - 2) : t - (TS - 2);
#pragma unroll
                for (int bj = 0; bj < 2; ++bj) { const int col = colt + bj * 128; const f32x4 v0 = acc[ai][bj][m][0], v1 = acc[ai][bj][m][1];
                    u32x4 w; w.x = pk2(v0.x, v0.y); w.y = pk2(v0.z, v0.w); w.z = pk2(v1.x, v1.y); w.w = pk2(v1.z, v1.w); *(u32x4*)(dstm + (size_t)row * DFFP + col) = w;
                    if (!isup && tl >= 0 && col < DFF) { float* dst = (isp ? out + O_FCP : out + O_FCS) + ((size_t)b * 2 + tl) * DFF + col; *(f32x4*)dst = v0; *(f32x4*)(dst + 4) = v1; } } }
    }
};
struct EpiBf {
    static constexpr bool PERM = false, AFTER_DRAIN = false;
    bf16* O; int ldc;
    __device__ __forceinline__ void operator()(const pg8::f32x4 (&acc)[2][2][4][2], const pg8::Unit& u, int wr, int wc, int fr, int fq) const {
#pragma unroll
        for (int ai = 0; ai < 2; ++ai)
#pragma unroll
            for (int m = 0; m < 4; ++m) { bf16* rowp = O + (size_t)(u.pm * 256 + ai * 128 + wr * 64 + m * 16 + fr) * ldc + u.pn * 256 + wc * 32 + fq * 4;
#pragma unroll
                for (int bj = 0; bj < 2; ++bj)
#pragma unroll
                    for (int n = 0; n < 2; ++n) { const f32x4 v = acc[ai][bj][m][n]; u32x2 w; w.x = pk2(v.x, v.y); w.y = pk2(v.z, v.w); *(u32x2*)(rowp + bj * 128 + n * 16) = w; } }
    }
};
DI void bf8_to_f(const u32x4 p, float (&f)[8]) { f[0] = __uint_as_float(p.x << 16); f[1] = __uint_as_float(p.x & 0xffff0000u); f[2] = __uint_as_float(p.y << 16); f[3] = __uint_as_float(p.y & 0xffff0000u);
    f[4] = __uint_as_float(p.z << 16); f[5] = __uint_as_float(p.z & 0xffff0000u); f[6] = __uint_as_float(p.w << 16); f[7] = __uint_as_float(p.w & 0xffff0000u); }
DI void act_pass(Frame& F, int R) {
    const bf16* GP = wsp<bf16>(F, WS_GP); const bf16* UP = wsp<bf16>(F, WS_UP); bf16* ACT = wsp<bf16>(F, WS_ACT);
    const float* dww = inp(F, I_DWW); const float* dwb = inp(F, I_DWB); const float* hist = inp(F, I_FCONV);
    const int gt = F.vcu * NTHR + F.tid, NGT = F.G * NTHR; constexpr int NR = 4, NCG = DFFP / 8, NITEM = (MT / NR) * NCG;
    for (int ii = gt; ii < NITEM * R; ii += NGT) { const int it = ii % NITEM; const int rq = it / NCG, cg = it % NCG, c0 = cg * 8, row0 = rq * NR;
        if (c0 >= DFF) {
#pragma unroll
            for (int k = 0; k < NR; ++k) *(u32x4*)(ACT + (size_t)(row0 + k) * DFFP + c0) = (u32x4){0u, 0u, 0u, 0u};
            continue; }
        const bool isp = row0 < MP; const int b = isp ? (row0 >> 11) : ((row0 - MP) >> 3); const int t0 = isp ? (row0 & 2047) : ((row0 - MP) & 7);
        float g[NR + 2][8];
#pragma unroll
        for (int k = 0; k < NR + 2; ++k) { const int tt = t0 - 2 + k;
            if (tt >= 0) bf8_to_f(*(const u32x4*)(GP + (size_t)(row0 - 2 + k) * DFFP + c0), g[k]);
            else if (isp) {
#pragma unroll
                for (int e = 0; e < 8; ++e) g[k][e] = 0.f; }
            else { const f32x4 h0 = *(const f32x4*)(hist + ((size_t)b * 2 + (2 + tt)) * DFF + c0), h1 = *(const f32x4*)(hist + ((size_t)b * 2 + (2 + tt)) * DFF + c0 + 4);
                g[k][0] = h0.x; g[k][1] = h0.y; g[k][2] = h0.z; g[k][3] = h0.w; g[k][4] = h1.x; g[k][5] = h1.y; g[k][6] = h1.z; g[k][7] = h1.w; } }
        float w0[8], w1[8], w2[8], bb[8];
#pragma unroll
        for (int e = 0; e < 8; e += 4) { const f32x4 a = *(const f32x4*)(dww + c0 + e), bq = *(const f32x4*)(dww + DFF + c0 + e), cq = *(const f32x4*)(dww + 2 * DFF + c0 + e), dq = *(const f32x4*)(dwb + c0 + e);
            w0[e] = a.x; w0[e + 1] = a.y; w0[e + 2] = a.z; w0[e + 3] = a.w; w1[e] = bq.x; w1[e + 1] = bq.y; w1[e + 2] = bq.z; w1[e + 3] = bq.w;
            w2[e] = cq.x; w2[e + 1] = cq.y; w2[e + 2] = cq.z; w2[e + 3] = cq.w; bb[e] = dq.x; bb[e + 1] = dq.y; bb[e + 2] = dq.z; bb[e + 3] = dq.w; }
#pragma unroll
        for (int k = 0; k < NR; ++k) { float up[8]; bf8_to_f(*(const u32x4*)(UP + (size_t)(row0 + k) * DFFP + c0), up); float a[8];
#pragma unroll
            for (int e = 0; e < 8; ++e) a[e] = gelu_tanh(bb[e] + w0[e] * g[k][e] + w1[e] * g[k + 1][e] + w2[e] * g[k + 2][e]) * up[e];
            u32x4 o; o.x = pk2(a[0], a[1]); o.y = pk2(a[2], a[3]); o.z = pk2(a[4], a[5]); o.w = pk2(a[6], a[7]); *(u32x4*)(ACT + (size_t)(row0 + k) * DFFP + c0) = o; }
    }
}

DI void compress_half(Frame& F, int it) {
    const int kv = it & 1, blk = (it >> 1) & 3, bb = it >> 3;
    const bool isp = bb < 4; const int b = isp ? bb : bb - 4;
    const int lane = F.lane, r = lane & 31, h = lane >> 5, w = F.wave, q = w & 3, half = w >> 2, tid = F.tid;
    const bf16* W12T = wsp<bf16>(F, WS_W12) + (size_t)kv * 256 * 1024;
    LAS unsigned char* AL = F.lds;
    LAS float* X = (LAS float*)F.lds;
    LAS bf16* G = (LAS bf16*)(F.lds + 65536);
    LAS int* ptl = (LAS int*)(F.lds + 130944);
    constexpr int ABUF = 132 * 272;
    __syncthreads();
    if (tid < 16) ptl[tid] = isp ? tid : F.pt[b * 16 + tid];
    __syncthreads();
    const unsigned char* sbase = (const unsigned char*)(isp ? F.out + O_KVP + (size_t)b * 2048 * 1024 : inp(F, I_CKV));
    const int rr = (tid >> 6) & 1;
    const bool x9 = tid < 128;
    unsigned pb[4];
#pragma unroll
    for (int k = 0; k < 4; ++k) pb[k] = ((unsigned)ptl[4 * blk + k] * 128u + (unsigned)((tid >> 7) * 16 + rr)) * 4096u + (unsigned)(kv * 1024 + (tid & 63) * 16);
    unsigned ro8; { int cg = x9 ? 32 * blk + 32 : 32 * blk + (tid >> 7); if (cg > 127) cg = 127; ro8 = ((unsigned)ptl[cg >> 3] * 128u + (unsigned)((cg & 7) * 16 + rr)) * 4096u + (unsigned)(kv * 1024 + (tid & 63) * 16); }
    LAS unsigned char* dum9 = AL + 2 * ABUF + tid * 8;
    const bool z9 = blk == 3;
    f32x4 rE[9], rO[9];
    const int s0 = (int)((blockIdx.x ^ (blockIdx.x >> 3)) & 7);
#define CMP_SIG(s_) ((unsigned)(((s_) + s0) & 7))
#define CMP_LOADA(ra, s_) do { const unsigned so_ = CMP_SIG(s_) * 8192u; _Pragma("unroll") for (int k = 0; k < 8; ++k) ra[k] = *(const f32x4*)(sbase + (pb[k >> 1] + (unsigned)((k & 1) * 262144) + so_)); \
        ra[8] = *(const f32x4*)(sbase + (ro8 + so_)); } while (0)
#define CMP_STOREA(ra, buf) do { LAS unsigned char* dst_ = AL + (buf) * ABUF + (((tid & 63) >> 4) * 33 + (tid >> 7)) * 272 + (rr * 64 + (tid & 15) * 4) * 2; \
        _Pragma("unroll") for (int k = 0; k < 8; ++k) { u32x2 p; p.x = pk2(ra[k].x, ra[k].y); p.y = pk2(ra[k].z, ra[k].w); *(LAS u32x2*)(dst_ + 4 * k * 272) = p; } \
        { u32x2 p; p.x = z9 ? 0u : pk2(ra[8].x, ra[8].y); p.y = z9 ? 0u : pk2(ra[8].z, ra[8].w); *(LAS u32x2*)(x9 ? dst_ + 32 * 272 : dum9) = p; } } while (0)
    const bf16* bp = W12T + ((size_t)(half * 4 + q) * 4096 + lane) * 8;
    bf16x8 wr[12];
#define CMP_LOADW(s_, t0) do { _Pragma("unroll") for (int t = (t0); t < (t0) + 4; ++t) wr[(8 * (s_) + t) % 12] = *(const bf16x8*)(bp + (8 * CMP_SIG(s_) + t) * 512); } while (0)
    f32x16 acc[4];
#pragma unroll
    for (int g = 0; g < 4; ++g) acc[g] = (f32x16){};
    CMP_LOADW(0, 0); CMP_LOADW(0, 4); CMP_LOADA(rE, 0); CMP_LOADW(1, 0); CMP_LOADA(rO, 1); CMP_STOREA(rE, 0); CMP_LOADA(rE, 2);
    __syncthreads();
#define CMP_MFMA4(s_, bufc, t0) do { const LAS unsigned char* Ab = AL + (bufc) * ABUF + (r + half) * 272 + 16 * h + 32 * (t0); bf16x8 fr[3];     \
          _Pragma("unroll") for (int i = 0; i < 3; ++i) fr[i] = *(const LAS bf16x8*)(Ab + (i & 3) * 33 * 272 + 32 * (i >> 2)); \
          _Pragma("unroll") for (int i = 0; i < 16; ++i) { acc[i & 3] = MFMA32(fr[i % 3], wr[(8 * (s_) + (t0) + (i >> 2)) % 12], acc[i & 3]); \
              if (i + 3 < 16) fr[i % 3] = *(const LAS bf16x8*)(Ab + ((i + 3) & 3) * 33 * 272 + 32 * ((i + 3) >> 2)); } \
          __builtin_amdgcn_sched_group_barrier(0x100, 3, 0); \
          _Pragma("unroll") for (int i = 0; i < 13; ++i) { __builtin_amdgcn_sched_group_barrier(0x008, 1, 0); __builtin_amdgcn_sched_group_barrier(0x100, 1, 0); } \
          __builtin_amdgcn_sched_group_barrier(0x008, 3, 0); } while (0)
#define CMP_SLICE(s_, bufc, rn) do { \
        CMP_MFMA4(s_, bufc, 0); \
        __builtin_amdgcn_sched_barrier(0); \
        if ((s_) + 1 < 8) CMP_LOADW((s_) + 1, 4); \
        __builtin_amdgcn_sched_barrier(0); \
        CMP_MFMA4(s_, bufc, 4); \
        __builtin_amdgcn_sched_barrier(0);                 \
        if ((s_) + 1 < 8) CMP_STOREA(rn, 1 - (bufc)); \
        if ((s_) + 2 < 8) CMP_LOADW((s_) + 2, 0); \
        if ((s_) + 3 < 8) CMP_LOADA(rn, (s_) + 3); \
        __syncthreads(); } while (0)
    CMP_SLICE(0, 0, rO); CMP_SLICE(1, 1, rE); CMP_SLICE(2, 0, rO); CMP_SLICE(3, 1, rE); CMP_SLICE(4, 0, rO); CMP_SLICE(5, 1, rE); CMP_SLICE(6, 0, rO); CMP_SLICE(7, 1, rE);
#undef CMP_MFMA4
#undef CMP_SLICE
#undef CMP_SIG
#undef CMP_LOADW
#undef CMP_LOADA
#undef CMP_STOREA
    int xb = 32 * q + r; asm volatile("" : "+v"(xb));
    float cb = inp(F, I_CB1)[kv * 128 + 32 * q + r];
    bf16x8 w2f[8]; float bb0;
    { const bf16* W2T = wsp<bf16>(F, WS_W2T) + (size_t)kv * 64 * 128;
#pragma unroll
      for (int ks = 0; ks < 8; ++ks) w2f[ks] = *(const bf16x8*)(W2T + (size_t)(32 * half + r) * 128 + 16 * ks + 8 * h);
      bb0 = inp(F, I_CB2)[kv * 64 + 32 * half + r]; }
    { const float* CBP = wsp<float>(F, WS_CBP) + kv * 8 * 128 + 32 * q + r;
#pragma unroll
      for (int p = 0; p < 8; ++p) cb += CBP[p * 128]; }
#define CMP_XPUT(g) do { _Pragma("unroll") for (int reg = 0; reg < 16; ++reg) X[(32 * (g) + crow(reg, h)) * 128 + xb] = acc[g][reg]; } while (0)
#define CMP_GELU(g) do { _Pragma("unroll") for (int reg = 0; reg < 16; ++reg) { const int n = 32 * (g) + crow(reg, h); \
        G[n * 136 + xb] = (bf16)(pk2(gelu_tanh(acc[g][reg] + X[n * 128 + xb] + cb), 0.f) & 0xffffu); } } while (0)
    if (half) { CMP_XPUT(0); CMP_XPUT(1); } else { CMP_XPUT(2); CMP_XPUT(3); }
    __syncthreads();
    if (half) { CMP_GELU(2); CMP_GELU(3); } else { CMP_GELU(0); CMP_GELU(1); }
#undef CMP_XPUT
#undef CMP_GELU
    __syncthreads();
    { const int g2 = q, dg = half; const int unit = (isp ? 0 : 16) + b * 4 + g2;
      f32x16 o0 = (f32x16){};
#pragma unroll
      for (int ks = 0; ks < 8; ++ks) { const bf16x8 af = *(const LAS bf16x8*)(G + (32 * g2 + r) * 136 + 16 * ks + 8 * h); o0 = MFMA32(af, w2f[ks], o0); }
      if (kv == 0) { bf16* KCK = wsp<bf16>(F, WS_KCK) + (size_t)unit * 8192;
#pragma unroll
          for (int reg = 0; reg < 16; ++reg) { const int n = 32 * blk + crow(reg, h); KCK[n * 64 + 32 * dg + r] = (bf16)(pk2(o0[reg] + bb0, 0.f) & 0xffffu); } }
      else { bf16* KCVT = wsp<bf16>(F, WS_KCVT) + (size_t)unit * 8192;
#pragma unroll
          for (int a = 0; a < 4; ++a) { const int n = 32 * blk + 8 * a + 4 * h;
              u32x2 x0; x0.x = pk2(o0[4 * a] + bb0, o0[4 * a + 1] + bb0); x0.y = pk2(o0[4 * a + 2] + bb0, o0[4 * a + 3] + bb0); *(u32x2*)(KCVT + (size_t)(32 * dg + r) * 128 + n) = x0; } }
    }
}

DI void ssm_pre(Frame& F, int rank, int nranks) {
    const float* XBC = wsp<float>(F, WS_XBC); float* XBCC = wsp<float>(F, WS_XBCC); const float* DTR = wsp<float>(F, WS_DTR); float* DT = wsp<float>(F, WS_DT);
    const float* cw = inp(F, I_SCW); const float* cbias = inp(F, I_SCB); const float* hist = inp(F, I_SCONV);
    const int gt = rank * NTHR + F.tid, NGT = nranks * NTHR;
    const int c = F.tid * 4;
    const f32x4 w0 = *(const f32x4*)(cw + c), w1 = *(const f32x4*)(cw + 2048 + c), w2 = *(const f32x4*)(cw + 2 * 2048 + c), w3 = *(const f32x4*)(cw + 3 * 2048 + c), bias = *(const f32x4*)(cbias + c);
    for (int i = gt; i < (MT / 4) * 512; i += NGT) { const int r0 = (i >> 9) * 4;
        const bool isp = r0 < MP; const int b = isp ? (r0 >> 11) : ((r0 - MP) >> 3); const int t0 = isp ? (r0 & 2047) : ((r0 - MP) & 7);
        f32x4 x[7];
#pragma unroll
        for (int j = 0; j < 4; ++j) x[3 + j] = *(const f32x4*)(XBC + (size_t)(r0 + j) * 2048 + c);
#pragma unroll
        for (int j = 1; j < 4; ++j) { const int tt = t0 - j;
            if (tt >= 0) x[3 - j] = *(const f32x4*)(XBC + (size_t)(r0 - j) * 2048 + c);
            else if (isp) x[3 - j] = (f32x4){0.f, 0.f, 0.f, 0.f};
            else x[3 - j] = *(const f32x4*)(hist + ((size_t)b * 3 + (3 + tt)) * 2048 + c); }
#pragma unroll
        for (int j = 0; j < 4; ++j) { f32x4 acc = bias; acc += w0 * x[j]; acc += w1 * x[j + 1]; acc += w2 * x[j + 2]; acc += w3 * x[j + 3];
            f32x4 o; o.x = siluf_(acc.x); o.y = siluf_(acc.y); o.z = siluf_(acc.z); o.w = siluf_(acc.w);
            *(f32x4*)(XBCC + (size_t)(r0 + j) * 2048 + c) = o;
            const int t = t0 + j;
            if (isp) { if (t >= TP - 3) *(f32x4*)(F.out + O_SCP + ((size_t)b * 3 + (t - (TP - 3))) * 2048 + c) = x[3 + j]; }
            else { if (t >= TS - 3) *(f32x4*)(F.out + O_SCS + ((size_t)b * 3 + (t - (TS - 3))) * 2048 + c) = x[3 + j]; } }
    }
    for (int i = gt; i < MT * 16; i += NGT) DT[i] = softplusf_(DTR[i] + inp(F, I_DTB)[i & 15]);
}

struct AState { float m, l; f32x16 o0, o1; };
DI void astate_init(AState& s) { s.m = NEGF; s.l = 0.f; s.o0 = (f32x16){}; s.o1 = (f32x16){}; }
DI bf16x8 pack8(const f32x16& x, int s) {
    u32x4 p; p.x = pk2(x[8 * s], x[8 * s + 1]); p.y = pk2(x[8 * s + 2], x[8 * s + 3]); p.z = pk2(x[8 * s + 4], x[8 * s + 5]); p.w = pk2(x[8 * s + 6], x[8 * s + 7]); return __builtin_bit_cast(bf16x8, p);
}
constexpr float LOG2E = 1.4426950408889634f, SCL2 = 0.125f * 1.4426950408889634f;
struct MaskBias {
    int t;
    unsigned long long mask;
    bool use_mask;
    int kbase;
    int maxdist;
    int klimit;
    int hd;
    const LAS float* lut;
    DI float score(float raw, int tile, int kk, bool selbit) const {
        const int kidx = tile * 64 + kk, dist = t - (kbase + kidx);
        const bool valid = dist >= 0 && dist <= maxdist && kidx < klimit && selbit;
        const int dc = dist < 0 ? 0 : (dist > 127 ? 127 : dist);
        return valid ? raw * SCL2 + lut[dc * 16 + hd] : NEGF;
    }
    DI bool selbit(int tile) const { return use_mask ? (((mask >> tile) & 1ull) != 0ull) : true; }
};
struct TileBf { bf16x8 k[2][4]; s16x4 vlo[2][2][2], vhi[2][2][2]; };
struct KVbf {
    const bf16* K; const bf16* VT; int vpitch;
    typedef TileBf Tile;
    DI void load(TileBf& t, int tile, int r, int h) const {
#pragma unroll
        for (int kh = 0; kh < 2; ++kh)
#pragma unroll
            for (int step = 0; step < 4; ++step) t.k[kh][step] = *(const bf16x8*)(K + (size_t)(tile * 64 + kh * 32 + r) * 64 + step * 16 + h * 8);
#pragma unroll
        for (int kh = 0; kh < 2; ++kh)
#pragma unroll
            for (int s = 0; s < 2; ++s)
#pragma unroll
                for (int dg = 0; dg < 2; ++dg) { const bf16* p = VT + (size_t)(dg * 32 + r) * vpitch + tile * 64 + kh * 32 + s * 16 + h * 4; t.vlo[kh][s][dg] = *(const s16x4*)p; t.vhi[kh][s][dg] = *(const s16x4*)(p + 8); }
    }
    DI void load2(TileBf&, int, int, int) const {}
    static DI bf16x8 kf(const TileBf& t, int kh, int step) { return t.k[kh][step]; }
    static DI bf16x8 vf(const TileBf& t, int kh, int s, int dg) { return __builtin_shufflevector(t.vlo[kh][s][dg], t.vhi[kh][s][dg], 0, 1, 2, 3, 4, 5, 6, 7); }
    DI bf16x8 kfrag(int tile, int kh, int step, int r, int h) const { return *(const bf16x8*)(K + (size_t)(tile * 64 + kh * 32 + r) * 64 + step * 16 + h * 8); }
    DI bf16x8 vfrag(int tile, int kh, int s, int dg, int r, int h) const { const bf16* p = VT + (size_t)(dg * 32 + r) * vpitch + tile * 64 + kh * 32 + s * 16 + h * 4;
        const s16x4 lo = *(const s16x4*)p, hi = *(const s16x4*)(p + 8); return __builtin_shufflevector(lo, hi, 0, 1, 2, 3, 4, 5, 6, 7); }
};
struct KVf32 { __amdgpu_buffer_rsrc_t rs; int stride_b, koff_b, voff_b; };
DI void attn_half_f32(AState& st, const bf16x8 (&qf)[4], const KVf32& kv, int tile, int kh, const MaskBias& mb, int r, int h) {
    u32x4 kq[4][2]; unsigned vq[2][2][8];
    const int vk = r * kv.stride_b + h * 32, vv = 4 * h * kv.stride_b + r * 4;
#pragma unroll
    for (int step = 0; step < 4; ++step) { const int so = kh * 32 * kv.stride_b + kv.koff_b + step * 64;
        kq[step][0] = __builtin_amdgcn_raw_buffer_load_b128(kv.rs, vk, so, 0); kq[step][1] = __builtin_amdgcn_raw_buffer_load_b128(kv.rs, vk, so + 16, 0); }
#pragma unroll
    for (int s = 0; s < 2; ++s)
#pragma unroll
        for (int j = 0; j < 8; ++j) { const int so = (kh * 32 + 16 * s + 8 * (j >> 2) + (j & 3)) * kv.stride_b + kv.voff_b;
            vq[s][0][j] = __builtin_amdgcn_raw_buffer_load_b32(kv.rs, vv, so, 0); vq[s][1][j] = __builtin_amdgcn_raw_buffer_load_b32(kv.rs, vv, so + 128, 0); }
    f32x16 s0 = (f32x16){};
#pragma unroll
    for (int step = 0; step < 4; ++step) s0 = MFMA32(cvt8(__builtin_bit_cast(f32x4, kq[step][0]), __builtin_bit_cast(f32x4, kq[step][1])), qf[step], s0);
    float tmax = NEGF;
    const bool sb = mb.selbit(tile);
#pragma unroll
    for (int reg = 0; reg < 16; ++reg) { s0[reg] = mb.score(s0[reg], tile, kh * 32 + crow(reg, h), sb); tmax = fmaxf(tmax, s0[reg]); }
    tmax = fmaxf(tmax, __shfl_xor(tmax, 32));
    const bool grow = __any(tmax > st.m + 8.0f);
    const float mnew = grow ? fmaxf(st.m, tmax) : st.m, alpha = grow ? __builtin_amdgcn_exp2f(st.m - mnew) : 1.0f;
    float ls = 0.f;
    const float msub = fmaxf(mnew, -1e29f);
#pragma unroll
    for (int reg = 0; reg < 16; ++reg) { const float p0 = __builtin_amdgcn_exp2f(s0[reg] - msub); s0[reg] = p0; ls += p0; }
    ls += __shfl_xor(ls, 32);
    st.l = st.l * alpha + ls; st.m = mnew;
    if (grow && __any(alpha != 1.0f)) {
#pragma unroll
        for (int reg = 0; reg < 16; ++reg) { const float a = __shfl(alpha, crow(reg, h)); st.o0[reg] *= a; st.o1[reg] *= a; }
    }
#pragma unroll
    for (int s = 0; s < 2; ++s) { const bf16x8 pf = pack8(s0, s);
#pragma unroll
        for (int dg = 0; dg < 2; ++dg) { const unsigned* v = vq[s][dg]; u32x4 p;
            p.x = pk2(__uint_as_float(v[0]), __uint_as_float(v[1])); p.y = pk2(__uint_as_float(v[2]), __uint_as_float(v[3])); p.z = pk2(__uint_as_float(v[4]), __uint_as_float(v[5])); p.w = pk2(__uint_as_float(v[6]), __uint_as_float(v[7]));
            const bf16x8 vf = __builtin_bit_cast(bf16x8, p); if (dg == 0) st.o0 = MFMA32(pf, vf, st.o0); else st.o1 = MFMA32(pf, vf, st.o1); } }
}
template <class KV> DI void attn_tile(AState& st, const bf16x8 (&qf)[4], const KV& kv, int tile, const MaskBias& mb, int r, int h, bool far = false) {
    typename KV::Tile tl; kv.load(tl, tile, r, h);
    f32x16 s0 = (f32x16){}, s1 = (f32x16){};
#pragma unroll
    for (int step = 0; step < 4; ++step) { s0 = MFMA32(KV::kf(tl, 0, step), qf[step], s0); s1 = MFMA32(KV::kf(tl, 1, step), qf[step], s1); }
    kv.load2(tl, tile, r, h);
    float tmax = NEGF; const bool sb = mb.selbit(tile);
    if (far) { const float cf = mb.lut[127 * 16 + mb.hd];
#pragma unroll
        for (int reg = 0; reg < 16; ++reg) { s0[reg] = sb ? s0[reg] * SCL2 + cf : NEGF; s1[reg] = sb ? s1[reg] * SCL2 + cf : NEGF; tmax = fmaxf(tmax, fmaxf(s0[reg], s1[reg])); } }
    else {
#pragma unroll
        for (int reg = 0; reg < 16; ++reg) { const int kk = crow(reg, h); s0[reg] = mb.score(s0[reg], tile, kk, sb); s1[reg] = mb.score(s1[reg], tile, 32 + kk, sb); tmax = fmaxf(tmax, fmaxf(s0[reg], s1[reg])); } }
    tmax = fmaxf(tmax, __shfl_xor(tmax, 32));
    const bool grow = __any(tmax > st.m + 8.0f);
    const float mnew = grow ? fmaxf(st.m, tmax) : st.m, alpha = grow ? __builtin_amdgcn_exp2f(st.m - mnew) : 1.0f;
    float ls = 0.f;
    const float msub = fmaxf(mnew, -1e29f);
#pragma unroll
    for (int reg = 0; reg < 16; ++reg) { const float p0 = __builtin_amdgcn_exp2f(s0[reg] - msub), p1 = __builtin_amdgcn_exp2f(s1[reg] - msub); s0[reg] = p0; s1[reg] = p1; ls += p0 + p1; }
    ls += __shfl_xor(ls, 32);
    st.l = st.l * alpha + ls; st.m = mnew;
    if (grow && __any(alpha != 1.0f)) {
#pragma unroll
        for (int reg = 0; reg < 16; ++reg) { const float a = __shfl(alpha, crow(reg, h)); st.o0[reg] *= a; st.o1[reg] *= a; }
    }
#pragma unroll
    for (int s = 0; s < 2; ++s) { const bf16x8 pf = pack8(s0, s); st.o0 = MFMA32(pf, KV::vf(tl, 0, s, 0), st.o0); st.o1 = MFMA32(pf, KV::vf(tl, 0, s, 1), st.o1); }
#pragma unroll
    for (int s = 0; s < 2; ++s) { const bf16x8 pf = pack8(s1, s); st.o0 = MFMA32(pf, KV::vf(tl, 1, s, 0), st.o0); st.o1 = MFMA32(pf, KV::vf(tl, 1, s, 1), st.o1); }
}
template <int CTRL> DI float qperm(float x) { return __int_as_float(__builtin_amdgcn_mov_dpp(__float_as_int(x), CTRL, 0xf, 0xf, true)); }
DI unsigned long long cmp_branch(const bf16x8 (&qf)[4], const bf16* KCK, const bf16* KCVT, int tq, int hd, const LAS float* lut, int ns, volatile LAS float* scr, f32x16& oc0, f32x16& oc1, int lane) {
    const int r = lane & 31, h = lane >> 5, qi = r >> 2;
    KVbf kv{KCK, KCVT, 128};
    f32x16 S[4];
#pragma unroll
    for (int T = 0; T < 4; ++T) { S[T] = (f32x16){};
#pragma unroll
        for (int step = 0; step < 4; ++step) S[T] = MFMA32(kv.kfrag(T >> 1, T & 1, step, r, h), qf[step], S[T]); }
    asm volatile("" ::: "memory");
    float mx = NEGF;
#pragma unroll
    for (int T = 0; T < 4; ++T)
#pragma unroll
        for (int reg = 0; reg < 16; ++reg) { const int n = 32 * T + crow(reg, h), dist = tq - (16 * n + 31); const int dc = dist < 0 ? 0 : (dist > 127 ? 127 : dist);
            const float s = dist >= 0 ? S[T][reg] * SCL2 + lut[dc * 16 + hd] : NEGF; S[T][reg] = s; mx = fmaxf(mx, s); }
    mx = fmaxf(mx, __shfl_xor(mx, 32));
    float l = 0.f;
#pragma unroll
    for (int T = 0; T < 4; ++T)
#pragma unroll
        for (int reg = 0; reg < 16; ++reg) { const float p = S[T][reg] > -1e29f ? __builtin_amdgcn_exp2f(S[T][reg] - mx) : 0.f; S[T][reg] = p; l += p; }
    l += __shfl_xor(l, 32);
    const float inv = 1.0f / fmaxf(l, TINYF);
#pragma unroll
    for (int T = 0; T < 4; ++T) S[T] *= inv;
    volatile LAS float* impA = scr; volatile LAS float* impB = scr + 8 * 34;
#pragma unroll
    for (int T = 0; T < 4; ++T)
#pragma unroll
        for (int a = 0; a < 4; ++a) { float e = S[T][4 * a] + S[T][4 * a + 1] + S[T][4 * a + 2] + 0.5f * S[T][4 * a + 3], c = 0.5f * S[T][4 * a + 3];
            e += qperm<0xB1>(e); e += qperm<0x4E>(e); c += qperm<0xB1>(c); c += qperm<0x4E>(c);
            if ((r & 3) == 0) { const int s = 8 * T + 2 * a + h; impA[qi * 34 + s] = e; impB[qi * 34 + s + 1] = c; } }
    if (lane < 8) { impB[lane * 34] = 0.f; impA[lane * 34 + 32] = 0.f; }
    LDS_WAIT();
    volatile LAS float* vv = scr + 8 * 34 * 2 + 16;
#pragma unroll 1
    for (int pp = 0; pp < 4; ++pp) { const int qa = 2 * pp + h, s = r; const int tqa = __shfl(tq, qa * 4), qb = tqa >> 6;
        float my = impA[qa * 34 + s] + impB[qa * 34 + s]; if (s == 0 || s == qb || s == qb - 1) my += 1.0e4f;
        vv[qa * 32 + s] = (s <= qb) ? my : -3.0e38f; }
    LDS_WAIT();
#pragma unroll 1
    for (int pp = 0; pp < 4; ++pp) { const int qa = 2 * pp + h, s = r; const int tqa = __shfl(tq, qa * 4), qb = tqa >> 6;
        const float my = vv[qa * 32 + s]; int rank = 0;
#pragma unroll 8
        for (int s2 = 0; s2 < 32; ++s2) { const float v2 = vv[qa * 32 + s2]; rank += (v2 > my || (v2 == my && s2 < s)) ? 1 : 0; }
        const bool extra = (ns == 33) && (qb == 32);
        const bool selq = (s <= qb) && (rank < (extra ? 7 : 8));
        const unsigned long long bal = __ballot(selq);
        if (s == 0) { scr[8 * 34 * 2 + 2 * qa] = __uint_as_float(h ? (unsigned)(bal >> 32) : (unsigned)bal); scr[8 * 34 * 2 + 2 * qa + 1] = __uint_as_float(extra ? 1u : 0u); } }
    LDS_WAIT();
    const unsigned long long mask = (unsigned long long)__float_as_uint(scr[8 * 34 * 2 + 2 * qi]) | ((unsigned long long)__float_as_uint(scr[8 * 34 * 2 + 2 * qi + 1]) << 32);
    oc0 = (f32x16){}; oc1 = (f32x16){};
#pragma unroll
    for (int T = 0; T < 4; ++T)
#pragma unroll
        for (int s = 0; s < 2; ++s) { asm volatile("" ::: "memory"); const bf16x8 pf = pack8(S[T], s); oc0 = MFMA32(pf, kv.vfrag(T >> 1, T & 1, s, 0, r, h), oc0); oc1 = MFMA32(pf, kv.vfrag(T >> 1, T & 1, s, 1, r, h), oc1); }
    return mask;
}
DI void attn_prompt_unit(Frame& F, int wu, volatile LAS float* scr, volatile LAS float* ost) {
    const int lane = F.lane, r = lane & 31, h = lane >> 5, qi = r >> 2, rh = r & 3;
    const int bg = wu >> 8, qo = wu & 255, b = bg >> 2, g = bg & 3, t = 8 * qo + qi, row = b * 2048 + t, hd = g * 4 + rh;
    const LAS float* lut = (const LAS float*)(F.lds + LUT_OFF);
    const bf16* QB = wsp<bf16>(F, WS_QB);
    bf16x8 qf[4];
#pragma unroll
    for (int step = 0; step < 4; ++step) qf[step] = *(const bf16x8*)(QB + (size_t)row * 1024 + hd * 64 + step * 16 + h * 8);
    f32x16 oc0, oc1;
    if ((DBL >> 21) & 1) { const unsigned long long m0 = cmp_branch(qf, wsp<bf16>(F, WS_KCK) + (size_t)bg * 8192, wsp<bf16>(F, WS_KCVT) + (size_t)bg * 8192, t, hd, lut, 32, scr, oc0, oc1, lane); asm volatile("" :: "v"((unsigned)m0), "v"(oc0[0]), "v"(oc1[5])); }
    const unsigned long long mask = cmp_branch(qf, wsp<bf16>(F, WS_KCK) + (size_t)bg * 8192, wsp<bf16>(F, WS_KCVT) + (size_t)bg * 8192, t, hd, lut, 32, scr, oc0, oc1, lane);
    unsigned long long om = mask;
#pragma unroll
    for (int o = 4; o < 32; o <<= 1) om |= __shfl_xor(om, o);
    om = __shfl(om, 0);
    const int qb = qo >> 3;
    const float* GATE = wsp<float>(F, WS_GATE) + (size_t)row * 48;
    { const float f0 = GATE[hd];
#pragma unroll
      for (int reg = 0; reg < 16; ++reg) { const float a0 = __shfl(f0, crow(reg, h)); ost[(reg * 2) * 64 + lane] = a0 * oc0[reg]; ost[(reg * 2 + 1) * 64 + lane] = a0 * oc1[reg]; } }
    { AState ss; astate_init(ss);
      KVbf kv{wsp<bf16>(F, WS_KB) + (size_t)((b * 2 + 0) * 4 + g) * 2048 * 64, wsp<bf16>(F, WS_VT) + (size_t)((b * 2 + 0) * 4 + g) * 64 * 2048, 2048};
      MaskBias mb{t, mask, true, 0, 1 << 30, 1 << 30, hd, lut};
      if ((DBL >> 22) & 1) { AState d2; astate_init(d2); for (int j = 0; j <= qb; ++j) { if (!((om >> j) & 1ull)) continue; attn_tile(d2, qf, kv, j, mb, r, h, 64 * j <= 8 * qo - 176); } asm volatile("" :: "v"(d2.l), "v"(d2.o0[0]), "v"(d2.o1[7])); }
#pragma unroll 1
      for (int j = 0; j <= qb; ++j) { if (!((om >> j) & 1ull)) continue; attn_tile(ss, qf, kv, j, mb, r, h, 64 * j <= 8 * qo - 176); }
      const float f1 = GATE[16 + hd] / fmaxf(ss.l, TINYF);
#pragma unroll
      for (int reg = 0; reg < 16; ++reg) { const float a1 = __shfl(f1, crow(reg, h)); ost[(reg * 2) * 64 + lane] += a1 * ss.o0[reg]; ost[(reg * 2 + 1) * 64 + lane] += a1 * ss.o1[reg]; } }
    { AState sw; astate_init(sw);
      KVbf kv{wsp<bf16>(F, WS_KB) + (size_t)((b * 2 + 1) * 4 + g) * 2048 * 64, wsp<bf16>(F, WS_VT) + (size_t)((b * 2 + 1) * 4 + g) * 64 * 2048, 2048};
      MaskBias mb{t, 0ull, false, 0, 512, 1 << 30, hd, lut};
      const int j0 = (8 * qo - 512) < 0 ? 0 : ((8 * qo - 512) >> 6);
      if ((DBL >> 23) & 1) { AState d2; astate_init(d2); for (int j = j0; j <= qb; ++j) attn_tile(d2, qf, kv, j, mb, r, h, (64 * j <= 8 * qo - 176) && (64 * j >= 8 * qo - 505)); asm volatile("" :: "v"(d2.l), "v"(d2.o0[0]), "v"(d2.o1[7])); }
#pragma unroll 1
      for (int j = j0; j <= qb; ++j) attn_tile(sw, qf, kv, j, mb, r, h, (64 * j <= 8 * qo - 176) && (64 * j >= 8 * qo - 505));
      const float f2 = GATE[32 + hd] / fmaxf(sw.l, TINYF);
      bf16* MIX = wsp<bf16>(F, WS_MIX);
#pragma unroll
      for (int reg = 0; reg < 16; ++reg) { const int qr = crow(reg, h); const float a2 = __shfl(f2, qr);
          const float v0 = ost[(reg * 2) * 64 + lane] + a2 * sw.o0[reg], v1 = ost[(reg * 2 + 1) * 64 + lane] + a2 * sw.o1[reg];
          bf16* op = MIX + (size_t)(b * 2048 + 8 * qo + (qr >> 2)) * 2048 + (g * 4 + (qr & 3)) * 64;
          op[r] = (bf16)(pk2(v0, 0.f) & 0xffffu); op[32 + r] = (bf16)(pk2(v1, 0.f) & 0xffffu); } }
}
DI void attn_sample_unit(Frame& F, int su) {
    const int lane = F.lane, r = lane & 31, h = lane >> 5, qi = r >> 2, rh = r & 3, w = F.wave;
    const int b = su >> 2, g = su & 3, t = 2048 + qi, row = MP + b * 8 + qi, hd = g * 4 + rh;
    const LAS float* lut = (const LAS float*)(F.lds + LUT_OFF);
    volatile LAS float* scr = (volatile LAS float*)(F.lds + w * 4096);
    LAS float* MB_ = (LAS float*)(F.lds + 32768);
    LAS float* OB = (LAS float*)(F.lds + 32768 + 2048);
    LAS float* OUT = (LAS float*)(F.lds + 32768 + 2048 + 65536);
    const bf16* QB = wsp<bf16>(F, WS_QB);
    bf16x8 qf[4];
#pragma unroll
    for (int step = 0; step < 4; ++step) qf[step] = *(const bf16x8*)(QB + (size_t)row * 1024 + hd * 64 + step * 16 + h * 8);
    f32x16 oc0, oc1;
    const int unit = 16 + su;
    const unsigned long long mask = cmp_branch(qf, wsp<bf16>(F, WS_KCK) + (size_t)unit * 8192, wsp<bf16>(F, WS_KCVT) + (size_t)unit * 8192, t, hd, lut, 33, scr, oc0, oc1, lane);
    unsigned long long om = mask;
#pragma unroll
    for (int o = 4; o < 32; o <<= 1) om |= __shfl_xor(om, o);
    om = __shfl(om, 0);
    const float* GATE = wsp<float>(F, WS_GATE) + (size_t)row * 48;
    if (w == 0) { const float f0 = GATE[hd];
#pragma unroll
        for (int reg = 0; reg < 16; ++reg) { const int qr = crow(reg, h); const float a0 = __shfl(f0, qr); OUT[qr * 64 + r] = a0 * oc0[reg]; OUT[qr * 64 + 32 + r] = a0 * oc1[reg]; } }
#pragma unroll 1
    for (int br = 0; br < 2; ++br) {
        AState st; astate_init(st);
        if (br == 0) { MaskBias mb{t, mask, true, 0, 1 << 30, 2056, hd, lut}; const float* cache = inp(F, I_CKV); const int* ptb = F.pt + b * 16;
            for (int j = w; j < 33; j += 8) { if (!((om >> j) & 1ull)) continue;
                KVf32 kv; kv.stride_b = 4096; kv.koff_b = (2 * 256 + g * 64) * 4; kv.voff_b = (3 * 256 + g * 64) * 4;
                if (j < 32) { const int page = __builtin_amdgcn_readfirstlane(ptb[j >> 1]); kv.rs = __builtin_amdgcn_make_buffer_rsrc((void*)(cache + ((size_t)page * 128 + (j & 1) * 64) * 1024), 0, 64 * 4096, 0x00020000); }
                else kv.rs = __builtin_amdgcn_make_buffer_rsrc((void*)(F.out + O_KVS + (size_t)b * 8 * 1024), 0, 8 * 4096, 0x00020000);
                attn_half_f32(st, qf, kv, j, 0, mb, r, h); attn_half_f32(st, qf, kv, j, 1, mb, r, h); } }
        else { MaskBias mb{t, 0ull, false, 1536, 512, 520, hd, lut};
            for (int j = (w == 7 ? 7 : w); j < 9; j += (w == 7 ? 1 : 16)) {
                KVf32 kv; kv.stride_b = 2048; kv.koff_b = (g * 64) * 4; kv.voff_b = (256 + g * 64) * 4;
                if (j < 8) kv.rs = __builtin_amdgcn_make_buffer_rsrc((void*)(inp(F, I_CWIN) + (size_t)b * 512 * 512 + (size_t)(64 * j) * 512), 0, 64 * 2048, 0x00020000);
                else kv.rs = __builtin_amdgcn_make_buffer_rsrc((void*)(F.out + O_WINS + (size_t)b * 512 * 512 + (size_t)504 * 512), 0, 8 * 2048, 0x00020000);
                attn_half_f32(st, qf, kv, j, 0, mb, r, h); attn_half_f32(st, qf, kv, j, 1, mb, r, h); } }
        __syncthreads();
        if (h == 0) { MB_[w * 32 + r] = st.m; MB_[256 + w * 32 + r] = st.l; }
#pragma unroll
        for (int reg = 0; reg < 16; ++reg) { const int qr = crow(reg, h); OB[(w * 32 + qr) * 64 + r] = st.o0[reg]; OB[(w * 32 + qr) * 64 + 32 + r] = st.o1[reg]; }
        __syncthreads();
        { const int qr = F.tid >> 4, d4 = (F.tid & 15) * 4; float M = NEGF;
#pragma unroll
          for (int ww = 0; ww < 8; ++ww) M = fmaxf(M, MB_[ww * 32 + qr]);
          float L = 0.f; f32x4 O = {0.f, 0.f, 0.f, 0.f};
#pragma unroll
          for (int ww = 0; ww < 8; ++ww) { const float e = __builtin_amdgcn_exp2f(MB_[ww * 32 + qr] - M); L += MB_[256 + ww * 32 + qr] * e; O += *(const LAS f32x4*)(OB + (ww * 32 + qr) * 64 + d4) * e; }
          const float gt = wsp<float>(F, WS_GATE)[(size_t)(MP + b * 8 + (qr >> 2)) * 48 + (br + 1) * 16 + g * 4 + (qr & 3)] / fmaxf(L, TINYF);
          *(LAS f32x4*)(OUT + qr * 64 + d4) += O * gt; }
    }
    __syncthreads();
    { const int qr = F.tid >> 4, d4 = (F.tid & 15) * 4; const f32x4 v = *(const LAS f32x4*)(OUT + qr * 64 + d4);
      u32x2 o; o.x = pk2(v.x, v.y); o.y = pk2(v.z, v.w); *(u32x2*)(wsp<bf16>(F, WS_MIX) + (size_t)(MP + b * 8 + (qr >> 2)) * 2048 + (g * 4 + (qr & 3)) * 64 + d4) = o; }
    __syncthreads();
}

struct KVlds {
    const LAS unsigned char* kimg; const LAS unsigned char* vimg;
    DI bf16x8 kfrag(int kh, int step, int r, int h) const { return *(const LAS bf16x8*)(kimg + (kh * 32 + r) * 144 + (step * 16 + h * 8) * 2); }
    DI bf16x8 vfrag(int kh, int s, int dg, int r, int h) const { const LAS unsigned char* p = vimg + (dg * 32 + r) * 136 + (kh * 32 + s * 16 + h * 4) * 2;
        const s16x4 lo = *(const LAS s16x4*)p, hi = *(const LAS s16x4*)(p + 16); return __builtin_shufflevector(lo, hi, 0, 1, 2, 3, 4, 5, 6, 7); }
};
DI void attn_tile_lds(AState& st, const bf16x8 (&qf)[4], const KVlds& kv, int tile, const MaskBias& mb, int r, int h, bool far) {
    f32x16 s0 = (f32x16){}, s1 = (f32x16){};
#pragma unroll
    for (int step = 0; step < 4; ++step) { s0 = MFMA32(kv.kfrag(0, step, r, h), qf[step], s0); s1 = MFMA32(kv.kfrag(1, step, r, h), qf[step], s1); }
    float tmax = NEGF; const bool sb = mb.selbit(tile);
    if (far) { const float cf = mb.lut[127 * 16 + mb.hd];
#pragma unroll
        for (int reg = 0; reg < 16; ++reg) { s0[reg] = sb ? s0[reg] * SCL2 + cf : NEGF; s1[reg] = sb ? s1[reg] * SCL2 + cf : NEGF; tmax = fmaxf(tmax, fmaxf(s0[reg], s1[reg])); } }
    else {
#pragma unroll
        for (int reg = 0; reg < 16; ++reg) { const int kk = crow(reg, h); s0[reg] = mb.score(s0[reg], tile, kk, sb); s1[reg] = mb.score(s1[reg], tile, 32 + kk, sb); tmax = fmaxf(tmax, fmaxf(s0[reg], s1[reg])); } }
    tmax = fmaxf(tmax, __shfl_xor(tmax, 32));
    const bool grow = __any(tmax > st.m + 8.0f);
    const float mnew = grow ? fmaxf(st.m, tmax) : st.m, alpha = grow ? __builtin_amdgcn_exp2f(st.m - mnew) : 1.0f;
    float ls = 0.f;
    const float msub = fmaxf(mnew, -1e29f);
#pragma unroll
    for (int reg = 0; reg < 16; ++reg) { const float p0 = __builtin_amdgcn_exp2f(s0[reg] - msub), p1 = __builtin_amdgcn_exp2f(s1[reg] - msub); s0[reg] = p0; s1[reg] = p1; ls += p0 + p1; }
    ls += __shfl_xor(ls, 32);
    st.l = st.l * alpha + ls; st.m = mnew;
    if (grow && __any(alpha != 1.0f)) {
#pragma unroll
        for (int reg = 0; reg < 16; ++reg) { const float a = __shfl(alpha, crow(reg, h)); st.o0[reg] *= a; st.o1[reg] *= a; }
    }
#pragma unroll
    for (int s = 0; s < 2; ++s) { const bf16x8 pf = pack8(s0, s); st.o0 = MFMA32(pf, kv.vfrag(0, s, 0, r, h), st.o0); st.o1 = MFMA32(pf, kv.vfrag(0, s, 1, r, h), st.o1); }
#pragma unroll
    for (int s = 0; s < 2; ++s) { const bf16x8 pf = pack8(s1, s); st.o0 = MFMA32(pf, kv.vfrag(1, s, 0, r, h), st.o0); st.o1 = MFMA32(pf, kv.vfrag(1, s, 1, r, h), st.o1); }
}
DI void attn_prompt_block(Frame& F, int blk) {
    const int lane = F.lane, r = lane & 31, h = lane >> 5, qi = r >> 2, rh = r & 3, w = F.wave, tid = F.tid;
    const int bg = blk >> 5, qb = blk & 31, b = bg >> 2, g = bg & 3, qo = 8 * qb + w, t = 8 * qo + qi, row = b * 2048 + t, hd = g * 4 + rh;
    const LAS float* lut = (const LAS float*)(F.lds + LUT_OFF);
    volatile LAS float* scr = (volatile LAS float*)(F.lds + w * 3328);
    LAS unsigned char* img = F.lds + 26624;
    volatile LAS float* ost = (volatile LAS float*)(F.lds + 62464 + w * 8192);
    const bf16* QB = wsp<bf16>(F, WS_QB);
    bf16x8 qf[4];
#pragma unroll
    for (int step = 0; step < 4; ++step) qf[step] = *(const bf16x8*)(QB + (size_t)row * 1024 + hd * 64 + step * 16 + h * 8);
    unsigned long long mask;
    { f32x16 oc0, oc1;
      if ((DBL >> 25) & 1) { const unsigned long long m0 = cmp_branch(qf, wsp<bf16>(F, WS_KCK) + (size_t)bg * 8192, wsp<bf16>(F, WS_KCVT) + (size_t)bg * 8192, t, hd, lut, 32, scr, oc0, oc1, lane); asm volatile("" :: "v"((unsigned)m0), "v"(oc0[0]), "v"(oc1[5])); }
      mask = cmp_branch(qf, wsp<bf16>(F, WS_KCK) + (size_t)bg * 8192, wsp<bf16>(F, WS_KCVT) + (size_t)bg * 8192, t, hd, lut, 32, scr, oc0, oc1, lane);
      const float f0 = wsp<float>(F, WS_GATE)[(size_t)row * 48 + hd];
#pragma unroll
      for (int reg = 0; reg < 16; ++reg) { const float a0 = __shfl(f0, crow(reg, h)); ost[(reg * 2) * 64 + lane] = a0 * oc0[reg]; ost[(reg * 2 + 1) * 64 + lane] = a0 * oc1[reg]; } }
    unsigned long long om = mask;
#pragma unroll
    for (int o = 4; o < 32; o <<= 1) om |= __shfl_xor(om, o);
    om = __shfl(om, 0);
    const int j0 = qb > 8 ? qb - 8 : 0, nsel = qb + 1, ntile = nsel + (qb - j0 + 1);
    const bf16* Ksel = wsp<bf16>(F, WS_KB) + (size_t)((b * 2 + 0) * 4 + g) * 2048 * 64; const bf16* Vsel = wsp<bf16>(F, WS_VT) + (size_t)((b * 2 + 0) * 4 + g) * 64 * 2048;
    const bf16* Kwin = wsp<bf16>(F, WS_KB) + (size_t)((b * 2 + 1) * 4 + g) * 2048 * 64; const bf16* Vwin = wsp<bf16>(F, WS_VT) + (size_t)((b * 2 + 1) * 4 + g) * 64 * 2048;
    u32x4 kreg, vreg;
#define APB_LOAD(i_) do { const bool ws_ = (i_) >= nsel; const int j_ = ws_ ? j0 + ((i_) - nsel) : (i_); \
        kreg = *(const u32x4*)((ws_ ? Kwin : Ksel) + (size_t)j_ * 4096 + tid * 8); vreg = *(const u32x4*)((ws_ ? Vwin : Vsel) + (size_t)(tid >> 3) * 2048 + j_ * 64 + (tid & 7) * 8); } while (0)
#define APB_STORE(buf_) do { LAS unsigned char* d_ = img + (buf_) * 17920; *(LAS u32x4*)(d_ + (tid >> 3) * 144 + (tid & 7) * 16) = kreg; \
        LAS unsigned char* v_ = d_ + 9216 + (tid >> 3) * 136 + (tid & 7) * 16; *(LAS u32x2*)v_ = (u32x2){kzero ? 0u : vreg.x, vreg.y}; *(LAS u32x2*)(v_ + 8) = (u32x2){vreg.z, vreg.w}; } while (0)
    const bool kzero = false;
    __syncthreads();
    APB_LOAD(0); APB_STORE(0);
    __syncthreads();
    AState st; astate_init(st);
    MaskBias mbs{t, mask, true, 0, 1 << 30, 1 << 30, hd, lut}, mbw{t, 0ull, false, 0, 512, 1 << 30, hd, lut};
    const float* GATE = wsp<float>(F, WS_GATE) + (size_t)row * 48;
#pragma unroll 1
    for (int i = 0; i < ntile; ++i) {
        if (i + 1 < ntile) APB_LOAD(i + 1);
        __builtin_amdgcn_sched_barrier(0);
        if (i == nsel) {
            const float f1 = GATE[16 + hd] / fmaxf(st.l, TINYF);
#pragma unroll
            for (int reg = 0; reg < 16; ++reg) { const float a1 = __shfl(f1, crow(reg, h)); ost[(reg * 2) * 64 + lane] += a1 * st.o0[reg]; ost[(reg * 2 + 1) * 64 + lane] += a1 * st.o1[reg]; }
            astate_init(st); }
        { const LAS unsigned char* d = img + (i & 1) * 17920; KVlds kv{d, d + 9216};
          if ((DBL >> 26) & 1) { AState d2; astate_init(d2); if (i < nsel) { if ((om >> i) & 1ull) attn_tile_lds(d2, qf, kv, i, mbs, r, h, 64 * i <= 8 * qo - 176); } else { const int j = j0 + (i - nsel); attn_tile_lds(d2, qf, kv, j, mbw, r, h, (64 * j <= 8 * qo - 176) && (64 * j >= 8 * qo - 505)); } asm volatile("" :: "v"(d2.l), "v"(d2.o0[0]), "v"(d2.o1[7])); }
          if (i < nsel) { if ((om >> i) & 1ull) attn_tile_lds(st, qf, kv, i, mbs, r, h, 64 * i <= 8 * qo - 176); }
          else { const int j = j0 + (i - nsel); attn_tile_lds(st, qf, kv, j, mbw, r, h, (64 * j <= 8 * qo - 176) && (64 * j >= 8 * qo - 505)); } }
        if (i + 1 < ntile) APB_STORE((i + 1) & 1);
        __syncthreads();
    }
#undef APB_LOAD
#undef APB_STORE
    { const float f2 = GATE[32 + hd] / fmaxf(st.l, TINYF);
      bf16* MIX = wsp<bf16>(F, WS_MIX);
#pragma unroll
      for (int reg = 0; reg < 16; ++reg) { const int qr = crow(reg, h); const float a2 = __shfl(f2, qr);
          const float v0 = ost[(reg * 2) * 64 + lane] + a2 * st.o0[reg], v1 = ost[(reg * 2 + 1) * 64 + lane] + a2 * st.o1[reg];
          bf16* op = MIX + (size_t)(b * 2048 + 8 * qo + (qr >> 2)) * 2048 + (g * 4 + (qr & 3)) * 64;
          op[r] = (bf16)(pk2(v0, 0.f) & 0xffffu); op[32 + r] = (bf16)(pk2(v1, 0.f) & 0xffffu); } }
}

DI void ssd_chunk_unit(Frame& F, int u) {
    const int lane = F.lane, r = lane & 31, h = lane >> 5, w = F.wave, tid = F.tid;
    const int g = u & 3, c = (u >> 2) & 15, b = u >> 6, row0 = b * 2048 + 128 * c;
    const float* XB = wsp<float>(F, WS_XBCC) + (size_t)row0 * 2048; const float* DTp = wsp<float>(F, WS_DT) + (size_t)row0 * 16;
    LAS float* acum = (LAS float*)F.lds;
    LAS float* dtv = acum + 512;
    LAS float* wexp = dtv + 512;
    LAS float* tot = wexp + 512;
    LAS unsigned char* Bb = F.lds + 8192;
    LAS unsigned char* XT = F.lds + 8192 + 128 * 272;
    __syncthreads();
    { f32x4 bv[8];
#pragma unroll
      for (int k = 0; k < 8; ++k) { const int f = tid + 512 * k; bv[k] = *(const f32x4*)(XB + (size_t)(f >> 5) * 2048 + 1024 + g * 128 + 4 * (f & 31)); }
      { const int hh = w >> 1, half = w & 1, i = 64 * half + lane, head = 4 * g + hh;
        const float A = -__expf(inp(F, I_ALOG)[head]); const float d = DTp[i * 16 + head];
        float a = d * A;
#pragma unroll
        for (int o = 1; o < 64; o <<= 1) { const float t = __shfl_up(a, o); if (lane >= o) a += t; }
        acum[hh * 128 + i] = a; dtv[hh * 128 + i] = d; if (lane == 63) tot[w] = a; }
#pragma unroll
      for (int k = 0; k < 8; ++k) { const int f = tid + 512 * k; u32x2 p; p.x = pk2(bv[k].x, bv[k].y); p.y = pk2(bv[k].z, bv[k].w); *(LAS u32x2*)(Bb + (f >> 5) * 272 + (f & 31) * 8) = p; } }
    __syncthreads();
    if (w & 1) acum[(w >> 1) * 128 + 64 + lane] += tot[w - 1];
    __syncthreads();
    { const int hh = tid >> 7, i = tid & 127; const float v = acum[hh * 128 + i];
      wsp<float>(F, WS_ACUM)[(size_t)(row0 + i) * 16 + 4 * g + hh] = v; if (i == 127) wsp<float>(F, WS_ATOT)[(b * 16 + c) * 16 + 4 * g + hh] = v;
      wexp[hh * 128 + i] = __expf(acum[hh * 128 + 127] - v); }
#pragma unroll 4
    for (int k = 0; k < 16; ++k) { const int f = tid + 512 * k, j = f >> 6, hp0 = 4 * (f & 63); const f32x4 xv = *(const f32x4*)(XB + (size_t)j * 2048 + (4 * g) * 64 + hp0); const float d = dtv[(hp0 >> 6) * 128 + j];
        LAS bf16* xp = (LAS bf16*)(XT + hp0 * 272) + j; const unsigned p0 = pk2(xv.x * d, xv.y * d), p1 = pk2(xv.z * d, xv.w * d);
        xp[0] = (bf16)(p0 & 0xffffu); xp[136] = (bf16)(p0 >> 16); xp[272] = (bf16)(p1 & 0xffffu); xp[408] = (bf16)(p1 >> 16); }
    __syncthreads();
    { const int it = w & 3, hp = w >> 2, i = 32 * it + r;
      const float ai0 = acum[(2 * hp) * 128 + i], ai1 = acum[(2 * hp + 1) * 128 + i];
      bf16x8 cf[8];
#pragma unroll
      for (int ks = 0; ks < 8; ++ks) { const float* p = XB + (size_t)i * 2048 + 1536 + g * 128 + 16 * ks + 8 * h; cf[ks] = cvt8(*(const f32x4*)p, *(const f32x4*)(p + 4)); }
      f32x16 Y00 = (f32x16){}, Y01 = (f32x16){}, Y10 = (f32x16){}, Y11 = (f32x16){};
#pragma unroll 1
      for (int jt = 0; jt <= it; ++jt) {
          f32x16 S = (f32x16){};
#pragma unroll
          for (int ks = 0; ks < 8; ++ks) S = MFMA32(*(const LAS bf16x8*)(Bb + (32 * jt + r) * 272 + (16 * ks + 8 * h) * 2), cf[ks], S);
#pragma unroll
          for (int e = 0; e < 2; ++e) { const int hh = 2 * hp + e; const float ai = e ? ai1 : ai0;
              f32x16 P;
#pragma unroll
              for (int reg = 0; reg < 16; ++reg) { const int j = 32 * jt + crow(reg, h); P[reg] = (j <= i) ? S[reg] * __expf(ai - acum[hh * 128 + j]) : 0.f; }
#pragma unroll
              for (int s = 0; s < 2; ++s) { const bf16x8 pf = pack8(P, s);
#pragma unroll
                  for (int dg = 0; dg < 2; ++dg) { const LAS unsigned char* vp = XT + (hh * 64 + 32 * dg + r) * 272 + (32 * jt + 16 * s + 4 * h) * 2;
                      const s16x4 lo = *(const LAS s16x4*)vp, hi = *(const LAS s16x4*)(vp + 16); const bf16x8 vf = __builtin_shufflevector(lo, hi, 0, 1, 2, 3, 4, 5, 6, 7);
                      if (e == 0) { if (dg == 0) Y00 = MFMA32(pf, vf, Y00); else Y01 = MFMA32(pf, vf, Y01); } else { if (dg == 0) Y10 = MFMA32(pf, vf, Y10); else Y11 = MFMA32(pf, vf, Y11); } } } }
      }
      float* YS = wsp<float>(F, WS_YSSM) + (size_t)row0 * 1024;
#pragma unroll
      for (int reg = 0; reg < 16; ++reg) { const int ii = 32 * it + crow(reg, h); float* yp = YS + (size_t)ii * 1024 + (4 * g + 2 * hp) * 64 + r;
          yp[0] = Y00[reg]; yp[32] = Y01[reg]; yp[64] = Y10[reg]; yp[96] = Y11[reg]; }
    }
    { const int hh = w >> 1, pt = w & 1, head = 4 * g + hh;
      f32x16 a0 = (f32x16){}, a1 = (f32x16){}, a2 = (f32x16){}, a3 = (f32x16){};
#pragma unroll 2
      for (int ks = 0; ks < 8; ++ks) {
          const u32x4 raw = *(const LAS u32x4*)(XT + (hh * 64 + 32 * pt + r) * 272 + (16 * ks + 8 * h) * 2);
          const LAS float* wp = wexp + hh * 128 + 16 * ks + 8 * h;
          u32x4 q;
          q.x = pk2(__uint_as_float(raw.x << 16) * wp[0], __uint_as_float(raw.x & 0xffff0000u) * wp[1]); q.y = pk2(__uint_as_float(raw.y << 16) * wp[2], __uint_as_float(raw.y & 0xffff0000u) * wp[3]);
          q.z = pk2(__uint_as_float(raw.z << 16) * wp[4], __uint_as_float(raw.z & 0xffff0000u) * wp[5]); q.w = pk2(__uint_as_float(raw.w << 16) * wp[6], __uint_as_float(raw.w & 0xffff0000u) * wp[7]);
          const bf16x8 af = __builtin_bit_cast(bf16x8, q);
#pragma unroll
          for (int nt = 0; nt < 4; ++nt) { const LAS bf16* bp = (const LAS bf16*)(Bb + (16 * ks + 8 * h) * 272) + 32 * nt + r; u32x4 q2;
              q2.x = (unsigned)bp[0] | ((unsigned)bp[136] << 16); q2.y = (unsigned)bp[272] | ((unsigned)bp[408] << 16); q2.z = (unsigned)bp[544] | ((unsigned)bp[680] << 16); q2.w = (unsigned)bp[816] | ((unsigned)bp[952] << 16);
              const bf16x8 bfr = __builtin_bit_cast(bf16x8, q2);
              if (nt == 0) a0 = MFMA32(af, bfr, a0); else if (nt == 1) a1 = MFMA32(af, bfr, a1); else if (nt == 2) a2 = MFMA32(af, bfr, a2); else a3 = MFMA32(af, bfr, a3); } }
      float* SC = wsp<float>(F, WS_SC) + ((size_t)((b * 16 + c) * 16 + head) * 64) * 128;
#pragma unroll
      for (int reg = 0; reg < 16; ++reg) { float* sp = SC + (size_t)(32 * pt + crow(reg, h)) * 128 + r; sp[0] = a0[reg]; sp[32] = a1[reg]; sp[64] = a2[reg]; sp[96] = a3[reg]; }
    }
}
DI void ssd_state_pass(Frame& F) {
    const int gt = F.vcu * NTHR + F.tid, NGT = F.G * NTHR;
    const float* SC = wsp<float>(F, WS_SC); const float* ATOT = wsp<float>(F, WS_ATOT); bf16* HP = wsp<bf16>(F, WS_HPREV);
    for (int e = gt; e < 131072; e += NGT) { const int b = e >> 15, rest = e & 32767, head = rest >> 11;
        f32x4 hs = {0.f, 0.f, 0.f, 0.f};
        f32x4 sc[16]; float at[16];
#pragma unroll
        for (int c = 0; c < 16; ++c) { sc[c] = *(const f32x4*)(SC + ((size_t)(b * 16 + c) * 32768 + rest) * 4); at[c] = ATOT[(b * 16 + c) * 16 + head]; }
#pragma unroll
        for (int c = 0; c < 16; ++c) { const size_t off = ((size_t)(b * 16 + c) * 32768 + rest) * 4;
            u32x2 o; o.x = pk2(hs.x, hs.y); o.y = pk2(hs.z, hs.w); *(u32x2*)(HP + off) = o;
            hs = hs * __expf(at[c]) + sc[c]; }
        *(f32x4*)(F.out + O_SSP + ((size_t)b * 32768 + rest) * 4) = hs; }
}
DI void ssd_out_unit(Frame& F, int u) {
    const int lane = F.lane, r = lane & 31, h = lane >> 5, w = F.wave;
    const int g = u & 3, c = (u >> 2) & 15, b = u >> 6, row0 = b * 2048 + 128 * c;
    const int hh = w >> 1, ih = w & 1, head = 4 * g + hh;
    const float* XB = wsp<float>(F, WS_XBCC) + (size_t)row0 * 2048;
    const bf16* HP = wsp<bf16>(F, WS_HPREV) + ((size_t)((b * 16 + c) * 16 + head) * 64) * 128;
    LAS float* part = (LAS float*)F.lds;
    f32x16 acc[2][2];
#pragma unroll
    for (int a = 0; a < 2; ++a)
#pragma unroll
        for (int d = 0; d < 2; ++d) acc[a][d] = (f32x16){};
#pragma unroll 2
    for (int ks = 0; ks < 8; ++ks) {
        const bf16x8 h0 = *(const bf16x8*)(HP + (size_t)r * 128 + 16 * ks + 8 * h), h1 = *(const bf16x8*)(HP + (size_t)(32 + r) * 128 + 16 * ks + 8 * h);
#pragma unroll
        for (int a = 0; a < 2; ++a) { const float* p = XB + (size_t)(64 * ih + 32 * a + r) * 2048 + 1536 + g * 128 + 16 * ks + 8 * h; const bf16x8 cfr = cvt8(*(const f32x4*)p, *(const f32x4*)(p + 4));
            acc[a][0] = MFMA32(cfr, h0, acc[a][0]); acc[a][1] = MFMA32(cfr, h1, acc[a][1]); } }
    const float* YS = wsp<float>(F, WS_YSSM) + (size_t)row0 * 1024; const float* ZF = wsp<float>(F, WS_ZF) + (size_t)row0 * 1024; const float* AC = wsp<float>(F, WS_ACUM) + (size_t)row0 * 16;
    const float D = inp(F, I_SD)[head];
    __syncthreads();
    int ib = 64 * ih + 4 * h;
#pragma unroll
    for (int a = 0; a < 2; ++a)
#pragma unroll
        for (int reg = 0; reg < 16; ++reg) { if ((reg & 7) == 0) asm volatile("" : "+v"(ib) :: "memory"); const int i = ib + 32 * a + (reg & 3) + 8 * (reg >> 2); const float ea = __expf(AC[i * 16 + head]); float ssq = 0.f;
#pragma unroll
            for (int d = 0; d < 2; ++d) { const int col = head * 64 + 32 * d + r; float y = YS[(size_t)i * 1024 + col] + ea * acc[a][d][reg] + D * XB[(size_t)i * 2048 + col]; y *= siluf_(ZF[(size_t)i * 1024 + col]); acc[a][d][reg] = y; ssq += y * y; }
            ssq += __shfl_xor(ssq, 1); ssq += __shfl_xor(ssq, 2); ssq += __shfl_xor(ssq, 4); ssq += __shfl_xor(ssq, 8); ssq += __shfl_xor(ssq, 16);
            if (r == 0) part[hh * 128 + i] = ssq; }
    __syncthreads();
    bf16* MIX = wsp<bf16>(F, WS_MIX) + (size_t)row0 * 2048 + 1024;
    const float g0 = inp(F, I_SNG)[head * 64 + r], g1 = inp(F, I_SNG)[head * 64 + 32 + r];
#pragma unroll
    for (int a = 0; a < 2; ++a)
#pragma unroll
        for (int reg = 0; reg < 16; ++reg) { if ((reg & 3) == 0) asm volatile("" : "+v"(ib) :: "memory"); const int i = ib + 32 * a + (reg & 3) + 8 * (reg >> 2);
            const float ss = (part[i] + part[128 + i]) + (part[256 + i] + part[384 + i]); const float rs = 1.0f / sqrtf(ss * (1.f / 256.f) + EPS);
            bf16* op = MIX + (size_t)i * 2048 + head * 64 + r;
            op[0] = (bf16)(pk2(acc[a][0][reg] * rs * g0, 0.f) & 0xffffu); op[32] = (bf16)(pk2(acc[a][1][reg] * rs * g1, 0.f) & 0xffffu); }
}

#ifndef BWPROBE
#define BWPROBE 0
#endif
#if BWPROBE > 0
DI void bw_probe(Frame& F) {
    const int tid = F.tid; const float* cache = inp(F, I_CKV); f32x4 acc = {0.f, 0.f, 0.f, 0.f};
#if BWPROBE == 6
    for (int hu = F.vcu; hu < 1024; hu += F.G) { const int b = hu >> 3, kv = (hu >> 2) & 1, mt = hu & 3;
        for (int s = 0; s < 16; ++s) {
#pragma unroll
            for (int k = 0; k < 4; ++k) { int f = tid + 512 * k; asm volatile("" : "+v"(f)); const int row = 32 * mt + (f >> 6);
                const float* p = cache + ((size_t)F.pt[b * 16 + (row >> 3)] * 128 + (row & 7) * 16 + s) * 1024 + kv * 256 + (f & 63) * 4;
                acc += *(const f32x4*)p; }
        } }
#elif BWPROBE == 9 || BWPROBE == 10
    for (int it = F.vcu; it < 1024; it += F.G) { const int kv = it & 1, blk = (it >> 1) & 3, b = it >> 3;
        unsigned ro[8];
#pragma unroll
        for (int k = 0; k < 8; ++k) { const int c = 32 * blk + (tid >> 7) + 4 * k; ro[k] = ((unsigned)F.pt[b * 16 + (c >> 3)] * 128u + (unsigned)((c & 7) * 16 + ((tid >> 6) & 1))) * 1024u; }
        const float* src = cache + kv * 256 + (tid & 63) * 4;
#pragma unroll 2
        for (int s = 0; s < 8; ++s) {
#pragma unroll
            for (int k = 0; k < 8; ++k) acc += *(const f32x4*)(src + (size_t)(ro[k] + (unsigned)s * 2048u));
#if BWPROBE == 10
            asm volatile("s_waitcnt vmcnt(0)" ::: "memory"); __syncthreads();
#endif
        } }
#elif BWPROBE == 7
    for (int hu = F.vcu; hu < 1024; hu += F.G) { const int b = hu >> 3, cb = hu & 7;
        for (int s = 0; s < 16; ++s) {
#pragma unroll
            for (int k = 0; k < 5; ++k) { int f = tid + 512 * k; asm volatile("" : "+v"(f)); if (f < 17 * 128) { int row = 16 * cb + (f >> 7); row = row > 127 ? 127 : row;
                const float* p = cache + ((size_t)F.pt[b * 16 + (row >> 3)] * 128 + (row & 7) * 16 + s) * 1024 + (f & 127) * 4;
                acc += *(const f32x4*)p; } }
        } }
#else
#if BWPROBE == 8
    if (F.vcu & 1) return;
    for (int hu = F.vcu >> 1; hu < 1024; hu += F.G / 2) { const int unit = hu >> 1, kv = hu & 1, b = unit >> 2, g = unit & 3;
#else
    for (int hu = F.vcu; hu < 1024; hu += F.G) { const int unit = hu >> 1, kv = hu & 1, b = unit >> 2, g = unit & 3;
#endif
        for (int s = 0; s < 16; ++s) {
#pragma unroll
            for (int k = 0; k < 4; ++k) {
#if BWPROBE == 1 || BWPROBE == 8
                int idx = (tid >> 4) + 32 * k; asm volatile("" : "+v"(idx)); const int row = idx, ss = s;
#else
                const int idx = (tid >> 4) + 32 * k; const int row = 8 * s + (idx >> 4), ss = idx & 15;
#endif
                const float* p = cache + ((size_t)F.pt[b * 16 + (row >> 3)] * 128 + (row & 7) * 16 + ss) * 1024 + kv * 256 + g * 64 + (tid & 15) * 4;
                acc += *(const f32x4*)p; }
        } }
#endif
    if (acc.x == 1.2345e38f) wsp<float>(F, WS_FFN)[tid] = acc.y + acc.z + acc.w;
}
#endif

template <int CTRL> DI float ror16(float x) { return __int_as_float(__builtin_amdgcn_mov_dpp(__float_as_int(x), CTRL, 0xf, 0xf, true)); }
struct EpiAct {
    static constexpr bool PERM = true, AFTER_DRAIN = false;
    unsigned char* ws; float* out; const float* dww; const float* dwb; const float* hist; LAS float* xb;
    __device__ __forceinline__ void operator()(const pg8::f32x4 (&acc)[2][2][4][2], const pg8::Unit& u, int wr, int wc, int fr, int fq) const {
        bf16* const ACT = (bf16*)(ws + WS_ACT); float* const HALO = (float*)(ws + WS_HALO); float* const FIXG = (float*)(ws + WS_FIXG); float* const FIXU = (float*)(ws + WS_FIXU);
        const int cloc = wc * 32 + fq * 8, ch0 = u.pn * 128 + cloc, pm = u.pm;
        const bool live = ch0 < DFF, isp = pm < 32, seqstart = isp && ((pm & 7) == 0);
        if (fr >= 14) {
#pragma unroll
            for (int ai = 0; ai < 2; ++ai)
#pragma unroll
                for (int n = 0; n < 2; ++n) *(LAS f32x4*)(xb + ((2 * ai + wr) * 2 + (fr - 14)) * 128 + cloc + 4 * n) = acc[ai][0][3][n]; }
        asm volatile("s_waitcnt lgkmcnt(0)" ::: "memory"); __builtin_amdgcn_s_barrier(); asm volatile("" ::: "memory");
        f32x4 w0[2], w1[2], w2[2], bb[2];
#pragma unroll
        for (int n = 0; n < 2; ++n) { const int c = live ? ch0 + 4 * n : 0; w0[n] = *(const f32x4*)(dww + c); w1[n] = *(const f32x4*)(dww + DFF + c); w2[n] = *(const f32x4*)(dww + 2 * DFF + c); bb[n] = *(const f32x4*)(dwb + c); }
#pragma unroll
        for (int ai = 0; ai < 2; ++ai) {
            const int blk = 2 * ai + wr;
            f32x4 P1[2], P2[2];
#pragma unroll
            for (int n = 0; n < 2; ++n) { if (blk > 0) { P1[n] = *(const LAS f32x4*)(xb + ((blk - 1) * 2 + 1) * 128 + cloc + 4 * n); P2[n] = *(const LAS f32x4*)(xb + ((blk - 1) * 2 + 0) * 128 + cloc + 4 * n); }
                                          else { P1[n] = (f32x4){0.f, 0.f, 0.f, 0.f}; P2[n] = (f32x4){0.f, 0.f, 0.f, 0.f}; } }
#pragma unroll
            for (int m = 0; m < 4; ++m) {
                const int row = pm * 256 + ai * 128 + wr * 64 + m * 16 + fr;
                u32x4 pk;
#pragma unroll
                for (int n = 0; n < 2; ++n) {
                    const f32x4 G0 = acc[ai][0][m][n], U = acc[ai][1][m][n]; f32x4 G1, G2;
#pragma unroll
                    for (int e = 0; e < 4; ++e) {
                        const float a1 = ror16<0x121>(G0[e]), a2 = ror16<0x122>(G0[e]); float b1, b2;
                        if (m > 0) { b1 = ror16<0x121>(acc[ai][0][m > 0 ? m - 1 : 0][n][e]); b2 = ror16<0x122>(acc[ai][0][m > 0 ? m - 1 : 0][n][e]); }
                        else { b1 = P1[n][e]; b2 = (fr == 0) ? P2[n][e] : P1[n][e]; }
                        G1[e] = fr >= 1 ? a1 : b1; G2[e] = fr >= 2 ? a2 : b2; }
                    if (!isp && live) { const int t = fr & 7, b = (row - MP) >> 3;
                        if (t == 0) { G1 = *(const f32x4*)(hist + ((size_t)b * 2 + 1) * DFF + ch0 + 4 * n); G2 = *(const f32x4*)(hist + ((size_t)b * 2 + 0) * DFF + ch0 + 4 * n); }
                        else if (t == 1) G2 = *(const f32x4*)(hist + ((size_t)b * 2 + 1) * DFF + ch0 + 4 * n); }
                    const f32x4 cv = bb[n] + w0[n] * G2 + w1[n] * G1 + w2[n] * G0;
                    f32x4 a; a.x = gelu_tanh(cv.x) * U.x; a.y = gelu_tanh(cv.y) * U.y; a.z = gelu_tanh(cv.z) * U.z; a.w = gelu_tanh(cv.w) * U.w;
                    if (!live) a = (f32x4){0.f, 0.f, 0.f, 0.f};
                    if (n == 0) { pk.x = pk2(a.x, a.y); pk.y = pk2(a.z, a.w); } else { pk.z = pk2(a.x, a.y); pk.w = pk2(a.z, a.w); }
                    if (live) {
                        const int tl = isp ? (row & 2047) - (TP - 2) : (row & 7) - (TS - 2);
                        if (tl >= 0) { const int b = isp ? (row >> 11) : ((row - MP) >> 3); *(f32x4*)((isp ? out + O_FCP : out + O_FCS) + ((size_t)b * 2 + tl) * DFF + ch0 + 4 * n) = G0; }
                        if (isp) {
                            if (blk == 3 && m == 3 && fr >= 14) *(f32x4*)(HALO + ((size_t)pm * 2 + (fr - 14)) * DFFP + ch0 + 4 * n) = G0;
                            if (blk == 0 && m == 0 && fr < 2) { *(f32x4*)(FIXG + ((size_t)pm * 2 + fr) * DFFP + ch0 + 4 * n) = G0; *(f32x4*)(FIXU + ((size_t)pm * 2 + fr) * DFFP + ch0 + 4 * n) = U; } } }
                }
                const bool deferred = live && isp && !seqstart && blk == 0 && m == 0 && fr < 2;
                if (!deferred) *(u32x4*)(ACT + (size_t)row * DFFP + ch0) = pk;
            }
        }
        asm volatile("s_waitcnt lgkmcnt(0)" ::: "memory"); __builtin_amdgcn_s_barrier(); asm volatile("" ::: "memory");
    }
};
DI void act_fixup(Frame& F, int pm) {
    if (pm >= 32 || (pm & 7) == 0) return;
    const float* HALO = wsp<float>(F, WS_HALO); const float* FIXG = wsp<float>(F, WS_FIXG); const float* FIXU = wsp<float>(F, WS_FIXU); bf16* ACT = wsp<bf16>(F, WS_ACT);
    const float* dww = inp(F, I_DWW); const float* dwb = inp(F, I_DWB);
    int c4 = F.tid; asm volatile("" : "+v"(c4));
    for (int c = c4 * 4; c < DFF; c += NTHR * 4) {
        const f32x4 gm2 = *(const f32x4*)(HALO + ((size_t)(pm - 1) * 2 + 0) * DFFP + c), gm1 = *(const f32x4*)(HALO + ((size_t)(pm - 1) * 2 + 1) * DFFP + c);
        const f32x4 g0 = *(const f32x4*)(FIXG + ((size_t)pm * 2 + 0) * DFFP + c), g1 = *(const f32x4*)(FIXG + ((size_t)pm * 2 + 1) * DFFP + c);
        const f32x4 u0 = *(const f32x4*)(FIXU + ((size_t)pm * 2 + 0) * DFFP + c), u1 = *(const f32x4*)(FIXU + ((size_t)pm * 2 + 1) * DFFP + c);
        const f32x4 w0 = *(const f32x4*)(dww + c), w1 = *(const f32x4*)(dww + DFF + c), w2 = *(const f32x4*)(dww + 2 * DFF + c), bb = *(const f32x4*)(dwb + c);
        const f32x4 c0 = bb + w0 * gm2 + w1 * gm1 + w2 * g0, c1 = bb + w0 * gm1 + w1 * g0 + w2 * g1;
        u32x2 o0, o1; o0.x = pk2(gelu_tanh(c0.x) * u0.x, gelu_tanh(c0.y) * u0.y); o0.y = pk2(gelu_tanh(c0.z) * u0.z, gelu_tanh(c0.w) * u0.w);
        o1.x = pk2(gelu_tanh(c1.x) * u1.x, gelu_tanh(c1.y) * u1.y); o1.y = pk2(gelu_tanh(c1.z) * u1.z, gelu_tanh(c1.w) * u1.w);
        *(u32x2*)(ACT + (size_t)(pm * 256) * DFFP + c) = o0; *(u32x2*)(ACT + (size_t)(pm * 256 + 1) * DFFP + c) = o1; }
    VM_WAIT(); __syncthreads();
}

DI void ssm_item(Frame& F, int its) {
    const int b = its >> 4, head = its & 15, g = head >> 2;
    const int row0 = MP + b * TS;
    const int pl = F.tid >> 5, nc = F.tid & 31;
    const float* XBCC = wsp<float>(F, WS_XBCC); const float* DT = wsp<float>(F, WS_DT); float* YS = wsp<float>(F, WS_YSSM);
    const float A = -__expf(inp(F, I_ALOG)[head]);
    const size_t soff = ((size_t)(b * 16 + head) * 64 + pl) * 128 + 4 * nc;
    f32x4 hs[4];
#pragma unroll
    for (int pq = 0; pq < 4; ++pq) hs[pq] = *(const f32x4*)(inp(F, I_SSM) + soff + (size_t)pq * 16 * 128);
    const float* xr = XBCC + (size_t)row0 * 2048;
    float part[32];
#pragma unroll
    for (int t = 0; t < TS; ++t) {
        const float* rp = xr + (size_t)t * 2048;
        const float dtv = DT[(size_t)(row0 + t) * 16 + head], dA = __expf(dtv * A);
        const f32x4 Bv = *(const f32x4*)(rp + 1024 + g * 128 + 4 * nc), Cv = *(const f32x4*)(rp + 1536 + g * 128 + 4 * nc);
#pragma unroll
        for (int pq = 0; pq < 4; ++pq) { const float x = rp[head * 64 + 16 * pq + pl] * dtv;
            hs[pq] = hs[pq] * dA + Bv * x;
            part[t * 4 + pq] = (Cv.x * hs[pq].x + Cv.y * hs[pq].y) + (Cv.z * hs[pq].z + Cv.w * hs[pq].w); }
    }
#pragma unroll
    for (int o = 16, c = 32; o >= 1; o >>= 1, c >>= 1) { const bool up = (nc & o) != 0;
#pragma unroll
        for (int i = 0; i < 16; ++i) if (i < c / 2) { const float lo = part[i], hi = part[i + c / 2]; const float recv = __shfl_xor(up ? lo : hi, o); part[i] = (up ? hi : lo) + recv; } }
    YS[(size_t)(row0 + (nc >> 2)) * 1024 + head * 64 + 16 * (nc & 3) + pl] = part[0];
#pragma unroll
    for (int pq = 0; pq < 4; ++pq) *(f32x4*)(F.out + O_SSS + soff + (size_t)pq * 16 * 128) = hs[pq];
}
DI void ssm_post(Frame& F) {
    const float* YS = wsp<float>(F, WS_YSSM); const float* XBCC = wsp<float>(F, WS_XBCC); const float* ZF = wsp<float>(F, WS_ZF); bf16* MIX = wsp<bf16>(F, WS_MIX);
    const int gw = F.vcu * NWAVES + F.wave, NGW = F.G * NWAVES, lane = F.lane;
    for (int i = gw; i < MS * 4; i += NGW) { const int row = MP + (i >> 2), g = i & 3, c = g * 256 + lane * 4;
        const f32x4 y = *(const f32x4*)(YS + (size_t)row * 1024 + c), x = *(const f32x4*)(XBCC + (size_t)row * 2048 + c), z = *(const f32x4*)(ZF + (size_t)row * 1024 + c);
        const float D = inp(F, I_SD)[c >> 6];
        f32x4 v = y + x * D; v.x *= siluf_(z.x); v.y *= siluf_(z.y); v.z *= siluf_(z.z); v.w *= siluf_(z.w);
        const float ss = wave_sum((v.x * v.x + v.y * v.y) + (v.z * v.z + v.w * v.w));
        const float rs = 1.0f / sqrtf(ss * (1.f / 256.f) + EPS);
        const f32x4 gg = *(const f32x4*)(inp(F, I_SNG) + c);
        u32x2 o; o.x = pk2(v.x * rs * gg.x, v.y * rs * gg.y); o.y = pk2(v.z * rs * gg.z, v.w * rs * gg.w);
        *(u32x2*)(MIX + (size_t)row * 2048 + 1024 + c) = o; }
}
DI void norm1(Frame& F) {
    const bf16* MIXO = wsp<bf16>(F, WS_MIXO); float* X1 = wsp<float>(F, WS_X1); bf16* H = wsp<bf16>(F, WS_XN);
    const float* SLAB = wsp<float>(F, WS_SLAB); const unsigned* flg = (const unsigned*)(F.ws + WS_CTL) + CW_FLAG6;
    const int gw = F.vcu * NWAVES + F.wave, NGW = F.G * NWAVES; int lane = F.lane; asm volatile("" : "+v"(lane));
#pragma unroll 1
    for (int m = gw; m < MT; m += NGW) {
        asm volatile("" : "+v"(lane));
        const u32x2* mr = (const u32x2*)(MIXO + (size_t)m * DM) + lane; const f32x4* xr = (const f32x4*)(m < MP ? inp(F, I_XP) + (size_t)m * DM : inp(F, I_XS) + (size_t)(m - MP) * DM) + lane;
        const f32x4* g1 = (const f32x4*)inp(F, I_LNPOST) + lane; const f32x4* g2 = (const f32x4*)inp(F, I_LNFPRE) + lane;
        f32x4 v[8], xv[8]; float s = 0.f;
#pragma unroll
        for (int j = 0; j < 8; ++j) xv[j] = xr[64 * j];
#pragma unroll
        for (int j = 0; j < 8; ++j) { const u32x2 p = mr[64 * j]; v[j] = (f32x4){__uint_as_float(p.x << 16), __uint_as_float(p.x & 0xffff0000u), __uint_as_float(p.y << 16), __uint_as_float(p.y & 0xffff0000u)}; }
        const u32x4 fa = *(const u32x4*)(flg + (m >> 8) * 8), fb = *(const u32x4*)(flg + (m >> 8) * 8 + 4);
        if ((fa.x | fa.y | fa.z | fa.w | fb.x | fb.y | fb.z | fb.w) != 0u) { const unsigned fl[8] = {fa.x, fa.y, fa.z, fa.w, fb.x, fb.y, fb.z, fb.w};
#pragma unroll
            for (int j = 0; j < 8; ++j) if (fl[j]) { const f32x4* sl = (const f32x4*)(SLAB + (size_t)m * DM) + lane + 64 * j; v[j] = (sl[0] + sl[(size_t)MT * DM / 4]) + (sl[(size_t)2 * MT * DM / 4] + sl[(size_t)3 * MT * DM / 4]); } }
#pragma unroll
        for (int j = 0; j < 8; ++j) s += (v[j].x * v[j].x + v[j].y * v[j].y) + (v[j].z * v[j].z + v[j].w * v[j].w);
        const float rs = 1.0f / sqrtf(wave_sum(s) * (1.f / DM) + EPS); float s2 = 0.f;
#pragma unroll
        for (int j = 0; j < 8; ++j) { v[j] = xv[j] + v[j] * rs * g1[64 * j]; s2 += (v[j].x * v[j].x + v[j].y * v[j].y) + (v[j].z * v[j].z + v[j].w * v[j].w); ((f32x4*)(X1 + (size_t)m * DM) + lane)[64 * j] = v[j]; }
        const float rs2 = 1.0f / sqrtf(wave_sum(s2) * (1.f / DM) + EPS);
        u32x2* o8 = (u32x2*)(H + (size_t)m * DM) + lane;
#pragma unroll
        for (int j = 0; j < 8; ++j) { const f32x4 gg = g2[64 * j]; u32x2 w; w.x = pk2(v[j].x * rs2 * gg.x, v[j].y * rs2 * gg.y); w.y = pk2(v[j].z * rs2 * gg.z, v[j].w * rs2 * gg.w); o8[64 * j] = w; }
    }
}
DI void norm2(Frame& F) {
    const bf16* FFN = wsp<bf16>(F, WS_FFN); const float* X1 = wsp<float>(F, WS_X1);
    const float* SLAB = wsp<float>(F, WS_SLAB); const unsigned* flg = (const unsigned*)(F.ws + WS_CTL) + CW_FLAG10;
    const int gw = F.vcu * NWAVES + F.wave, NGW = F.G * NWAVES; int lane; asm volatile("v_and_b32 %0, 63, %1" : "=v"(lane) : "v"((int)threadIdx.x));
#pragma unroll 1
    for (int m = gw; m < MT; m += NGW) {
        const u32x2* fr_ = (const u32x2*)(FFN + (size_t)m * DM) + lane; const f32x4* xr = (const f32x4*)(X1 + (size_t)m * DM) + lane; const f32x4* g3 = (const f32x4*)inp(F, I_LNFPOST) + lane;
        f32x4 v[8], xv[8]; float s = 0.f;
#pragma unroll
        for (int j = 0; j < 8; ++j) xv[j] = xr[64 * j];
#pragma unroll
        for (int j = 0; j < 8; ++j) { const u32x2 p = fr_[64 * j]; v[j] = (f32x4){__uint_as_float(p.x << 16), __uint_as_float(p.x & 0xffff0000u), __uint_as_float(p.y << 16), __uint_as_float(p.y & 0xffff0000u)}; }
        const u32x4 fa = *(const u32x4*)(flg + (m >> 8) * 8), fb = *(const u32x4*)(flg + (m >> 8) * 8 + 4);
        if ((fa.x | fa.y | fa.z | fa.w | fb.x | fb.y | fb.z | fb.w) != 0u) { const unsigned fl[8] = {fa.x, fa.y, fa.z, fa.w, fb.x, fb.y, fb.z, fb.w};
#pragma unroll
            for (int j = 0; j < 8; ++j) if (fl[j]) { const f32x4* sl = (const f32x4*)(SLAB + (size_t)m * DM) + lane + 64 * j; v[j] = (sl[0] + sl[(size_t)MT * DM / 4]) + (sl[(size_t)2 * MT * DM / 4] + sl[(size_t)3 * MT * DM / 4]); } }
#pragma unroll
        for (int j = 0; j < 8; ++j) s += (v[j].x * v[j].x + v[j].y * v[j].y) + (v[j].z * v[j].z + v[j].w * v[j].w);
        const float rs = 1.0f / sqrtf(wave_sum(s) * (1.f / DM) + EPS);
        f32x4* o = (f32x4*)(F.out + (m < MP ? O_YP + (size_t)m * DM : O_YS + (size_t)(m - MP) * DM)) + lane;
#pragma unroll
        for (int j = 0; j < 8; ++j) o[64 * j] = xv[j] + v[j] * rs * g3[64 * j];
    }
}

struct RepOrder {
    pg8::StaticOrder base; int cnt, reps, maxi;
    __device__ __forceinline__ void init(int M, int N, int G, int c, int reps_) { base.init(M, N, G, c); cnt = (base.nwg - c + G - 1) / G; if (cnt < 0) cnt = 0; reps = reps_; maxi = 1 << 30; }
    __device__ __forceinline__ bool next(int i, pg8::Unit& u) const { const int cn = cnt < maxi ? cnt : maxi; if (i >= cn * reps) return false; return base.next(reps == 1 ? i : i % cn, u); }
    __device__ __forceinline__ void a_ready(const pg8::Unit&) const {}
    __device__ __forceinline__ void done(const pg8::Unit&) const {}
};
struct OneOrder {
    pg8::Unit u; bool ok;
    __device__ __forceinline__ void init(int M, int N, int G, int L) { pg8::StaticOrder b; b.init(M, N, G, L % G); ok = b.next(L / G, u); }
    __device__ __forceinline__ bool next(int i, pg8::Unit& o) const { if (i != 0 || !ok) return false; o = u; return true; }
    __device__ __forceinline__ void a_ready(const pg8::Unit&) const {}
    __device__ __forceinline__ void done(const pg8::Unit&) const {}
};
constexpr int N_PHASES = 13;
struct Args { const void* in[N_IN]; float* out; unsigned char* ws; int ph_lo, ph_hi, pad0, pad1; };
__global__ void __launch_bounds__(NTHR, 2) hybrid_fwd(Args args) {
    extern __shared__ __attribute__((aligned(16))) unsigned char lds[];
    Frame F;
    F.lds = (LAS unsigned char*)lds;
    F.tid = threadIdx.x; F.lane = F.tid & 63; F.wave = __builtin_amdgcn_readfirstlane(F.tid >> 6);
    F.G = gridDim.x; { const int bx = blockIdx.x; F.vcu = (F.G % 8 == 0) ? (bx % 8) * (F.G / 8) + bx / 8 : bx; }
    F.ptab = (LAS unsigned*)(F.lds + PTAB_OFF);
    F.pt = (const int*)args.in[I_PT]; F.out = args.out; F.ws = args.ws;
    unsigned* ctl = (unsigned*)(F.ws + WS_CTL);
    for (int u = F.tid; u < (LDS_BYTES - LDSCTL_OFF) / 4; u += NTHR) ((LAS unsigned*)(F.lds + LDSCTL_OFF))[u] = 0u;
    __syncthreads();
#pragma unroll
    for (int i = 0; i < N_IN; ++i) if (F.tid == i) { const unsigned long long p = (unsigned long long)args.in[i]; F.ptab[2 * i] = (unsigned)p; F.ptab[2 * i + 1] = (unsigned)(p >> 32); }
    __syncthreads();
    const int lo = args.ph_lo, hi = args.ph_hi;
#if PROBE_PH >= 0
    volatile LAS unsigned long long* stamps = (volatile LAS unsigned long long*)(F.lds + LDSCTL_OFF);
#define STAMP(i) do { if (blockIdx.x == 0 && F.tid == 0) stamps[i] = __builtin_amdgcn_s_memrealtime(); } while (0)
#else
#define STAMP(i) do {} while (0)
#endif
    STAMP(0);
    XcdBarrier bar; bar.bar = ctl + CW_BAR; bar.x = 0; bar.st = nullptr;
    if (hi - lo > 1) bar = xcd_barrier_post(ctl + CW_BAR, (volatile LAS unsigned*)(F.lds + MISC_OFF) + 8);
#ifndef PH3_MASK
#define PH3_MASK 15
#endif
#ifndef PH_MASK
#define PH_MASK 0x1fff
#endif
#define IN(k) (((PH_MASK >> (k)) & 1) && lo <= (k) && (k) < hi)
#define SEAM(k) do { if (IN(k) && IN((k) + 1)) { xcd_barrier(bar); if ((DBL >> 18) & 1) xcd_barrier(bar); } STAMP((k) + 1); } while (0)
    LAS unsigned char* ring = F.lds;

#define RN(bit) (1 + ((DBL >> (bit)) & 1))
#define REP(bit) for (int rep_ = 0; rep_ < RN(bit); ++rep_)
    if (IN(0)) { ph0_prologue(F, RN(15), RN(16), RN(17)); } SEAM(0);
    if (IN(1)) {
        pg8::Gemm gm{wsp<bf16>(F, WS_XN), wsp<bf16>(F, WS_WIN), MT, NPROJ, DM, DM}; RepOrder S; S.init(MT, NPROJ, F.G, (int)blockIdx.x, RN(1));
        EpiProj E{F.ws, F.out};
        pg8::gemm_phase<EpiProj, RepOrder, true, true>(ring, gm, S, E);
        if (F.G == 256 && blockIdx.x >= 60) { compress_half(F, 32 + ((int)blockIdx.x - 60)); wd_convert_tail(F, (int)blockIdx.x - 60, 196); }
    } SEAM(1);
    if (IN(2)) { { const int nrem = (F.G == 256) ? 2 * NUNIT - 196 : 2 * NUNIT; for (int uu = F.vcu; uu < nrem * RN(2); uu += F.G) { const int j = uu % nrem; compress_half(F, (F.G == 256 && j >= 32) ? j + 196 : j); } if (PROBE_PH == 98) { __syncthreads(); STAMP(14); } }
        if (F.G == 256) { if (F.vcu >= 92) ssm_pre(F, F.vcu - 92, 164); }
        else ssm_pre(F, F.vcu, F.G); } SEAM(2);
    if (IN(3)) {
        { const float* LUT = wsp<float>(F, WS_LUT); LAS float* l = (LAS float*)(F.lds + LUT_OFF); int t0 = F.tid; asm volatile("" : "+v"(t0)); for (int i = t0; i < 2048; i += NTHR) l[i] = LUT[i] * LOG2E; }
        __syncthreads();
        if (PH3_MASK & 1) for (int uu = F.vcu; uu < 256 * RN(4); uu += F.G) ssd_chunk_unit(F, uu % 256);
        __syncthreads();
        if ((F.vcu & 1) == 0) {
            if (PH3_MASK & 2) for (int uu = F.vcu; uu < 256 * RN(5); uu += F.G) { const int u = uu % 256; attn_prompt_block(F, u); attn_prompt_block(F, 511 - u); }
            __syncthreads();
            if (PH3_MASK & 4) for (int uu = F.vcu; uu < 512 * RN(6); uu += F.G) attn_sample_unit(F, uu % 512);
            if (PH3_MASK & 8) for (int it = F.vcu; it < 2048 * RN(7); it += F.G) ssm_item(F, it % 2048);
        } else {
            if (PH3_MASK & 4) for (int uu = F.vcu; uu < 512 * RN(6); uu += F.G) attn_sample_unit(F, uu % 512);
            if (PH3_MASK & 8) for (int it = F.vcu; it < 2048 * RN(7); it += F.G) ssm_item(F, it % 2048);
            __syncthreads();
            if (PH3_MASK & 2) for (int uu = F.vcu; uu < 256 * RN(5); uu += F.G) { const int u = uu % 256; attn_prompt_block(F, u); attn_prompt_block(F, 511 - u); }
        }
    } SEAM(3);
    if (IN(4)) { REP(19) ssd_state_pass(F); REP(8) ssm_post(F); } SEAM(4);
    if (IN(5)) { for (int uu = F.vcu; uu < 256 * RN(20); uu += F.G) ssd_out_unit(F, uu % 256); } SEAM(5);
    if (IN(6)) {
        { pg8::Gemm gm{wsp<bf16>(F, WS_MIX), wsp<bf16>(F, WS_WOUT), MT, DM, DM, DM}; RepOrder S; S.init(MT, DM, F.G, (int)blockIdx.x, RN(9)); if (F.G == 256) S.maxi = 1;
          EpiBf16P E{wsp<bf16>(F, WS_MIXO), DM};
          pg8::gemm_phase<EpiBf16P, RepOrder, true, true>(ring, gm, S, E); }
        if (F.G == 256 && blockIdx.x < 128) { const int kp = blockIdx.x & 3;
          pg8::Gemm gm{wsp<bf16>(F, WS_MIX) + kp * (DM / 4), wsp<bf16>(F, WS_WOUT) + kp * (DM / 4), MT, DM, DM, DM / 4}; OneOrder S; S.init(MT, DM, F.G, 256 + ((int)blockIdx.x >> 2));
          EpiF32 E{wsp<float>(F, WS_SLAB) + (size_t)kp * MT * DM, DM};
          pg8::gemm_phase<EpiF32, OneOrder, true, true>(ring, gm, S, E);
          if (kp == 0 && F.tid == 0) ctl[CW_FLAG6 + S.u.pm * 8 + S.u.pn] = 1u; }
    } SEAM(6);
    if (IN(7)) { REP(10) norm1(F); } SEAM(7);
    if (IN(8)) {
        constexpr int NGU = 2 * DFF;
        pg8::Gemm gm{wsp<bf16>(F, WS_XN), wsp<bf16>(F, WS_WG), MT, NGU, DM, DM}; RepOrder S; S.init(MT, NGU, F.G, (int)blockIdx.x, RN(11));
        EpiAct E{F.ws, F.out, inp(F, I_DWW), inp(F, I_DWB), inp(F, I_FCONV), (LAS float*)(F.lds + LUT_OFF)};
        pg8::gemm_phase<EpiAct, RepOrder, true, true>(ring, gm, S, E);
        if (F.G == 256) { if (blockIdx.x >= 12) win_copy(F, (int)blockIdx.x - 12, 244, RN(16)); } else win_copy(F, F.vcu, F.G, RN(16));
    } SEAM(8);
    STAMP(10); STAMP(11);
    if (IN(11)) {
        { pg8::Gemm gm{wsp<bf16>(F, WS_ACT), wsp<bf16>(F, WS_WD), MT, DM, DFFP, DFFP}; RepOrder S; S.init(MT, DM, F.G, (int)blockIdx.x, RN(13)); if (F.G == 256) S.maxi = 1;
          EpiBf16P E{wsp<bf16>(F, WS_FFN), DM};
          { pg8::Unit uf; for (int i = 0; S.next(i, uf); ++i) act_fixup(F, uf.pm); }
          pg8::gemm_phase<EpiBf16P, RepOrder, true, true>(ring, gm, S, E); }
        if (F.G == 256 && blockIdx.x < 128) { const int kp = blockIdx.x & 3;
          pg8::Gemm gm{wsp<bf16>(F, WS_ACT) + kp * (DFFP / 4), wsp<bf16>(F, WS_WD) + kp * (DFFP / 4), MT, DM, DFFP, DFFP / 4}; OneOrder S; S.init(MT, DM, F.G, 256 + ((int)blockIdx.x >> 2));
          EpiF32 E{wsp<float>(F, WS_SLAB) + (size_t)kp * MT * DM, DM};
          if (S.ok) act_fixup(F, S.u.pm);
          pg8::gemm_phase<EpiF32, OneOrder, true, true>(ring, gm, S, E);
          if (kp == 0 && F.tid == 0) ctl[CW_FLAG10 + S.u.pm * 8 + S.u.pn] = 1u; }
    } SEAM(11);
    if (IN(12)) { REP(14) norm2(F); }
#if BWPROBE > 0
    __syncthreads(); bw_probe(F);
#endif
#if PROBE_PH >= 0
    STAMP(13);
    if (blockIdx.x == 0) { __syncthreads(); if (F.tid == 0) { const unsigned long long d = (PROBE_PH == 98 ? (stamps[14] - stamps[2]) : PROBE_PH == 99 ? (stamps[13] - stamps[0]) : (stamps[(PROBE_PH >= 98 ? 0 : PROBE_PH) + 1] - stamps[PROBE_PH >= 98 ? 0 : PROBE_PH])) * PROBE_AMP, t0 = __builtin_amdgcn_s_memrealtime(); while (__builtin_amdgcn_s_memrealtime() - t0 < d) __builtin_amdgcn_s_sleep(32); } __syncthreads(); }
#endif
#undef REP
#undef RN
#undef IN
#undef SEAM
}

extern "C" void kernel_launch(void* const* d_in, const int* in_sizes, int n_in, void* d_out, int out_size, void* d_ws, size_t ws_size, hipStream_t stream) {
    static int grid = 0;
    if (grid == 0) {
        if (n_in != N_IN || (size_t)out_size != O_END || ws_size < WS_END) { fprintf(stderr, "kernel_launch: unexpected shapes (n_in %d, out %d, ws %zu)\n", n_in, out_size, ws_size); grid = -1; return; }
        int dev = 0, cus = 0;
        if (hipGetDevice(&dev) != hipSuccess || hipDeviceGetAttribute(&cus, hipDeviceAttributeMultiprocessorCount, dev) != hipSuccess) { grid = -1; return; }
        if (hipFuncSetAttribute((const void*)hybrid_fwd, hipFuncAttributeMaxDynamicSharedMemorySize, LDS_BYTES) != hipSuccess) { fprintf(stderr, "kernel_launch: hipFuncSetAttribute failed\n"); grid = -1; return; }
        int per_cu = 0;
        if (hipOccupancyMaxActiveBlocksPerMultiprocessor(&per_cu, (const void*)hybrid_fwd, NTHR, LDS_BYTES) != hipSuccess || per_cu < 1) fprintf(stderr, "kernel_launch: occupancy query says %d\n", per_cu);
        (void)hipGetLastError();
        grid = cus;
    }
    if (grid < 0) return;
    (void)hipMemsetAsync((char*)d_ws + WS_CTL, 0, CTL_ZERO_BYTES, stream);
    Args a{};
    for (int i = 0; i < N_IN; ++i) a.in[i] = d_in[i];
    a.out = (float*)d_out; a.ws = (unsigned char*)d_ws;
#if MK_ONE_LAUNCH
    a.ph_lo = 0; a.ph_hi = N_PHASES;
    hipLaunchKernelGGL(hybrid_fwd, dim3(grid), dim3(NTHR), LDS_BYTES, stream, a);
#else
    for (int p = 0; p < N_PHASES; ++p) { a.ph_lo = p; a.ph_hi = p + 1; hipLaunchKernelGGL(hybrid_fwd, dim3(grid), dim3(NTHR), LDS_BYTES, stream, a); }
#endif
}
```
